# Optimizing an MI355X kernel written in HIP

```python
import math
import jax, jax.numpy as jnp
from jax import lax
import numpy as np

D_MODEL = 1024
BATCH = 8
SEQ = 4096
DEPTH = 4

D_FF = 2816
NORM_EPS = 1e-6
N_BRANCH = 4

GDN_HEADS = 4
GDN_DK = 64
GDN_DV = 64
GDN_CONV = 4
GDN_CHUNK = 64

S5_GROUPS = 16
S5_GROUP_WIDTH = 16
S5_STATE = 64
S5_WIDTH = S5_GROUPS * S5_GROUP_WIDTH

LRU_WIDTH = 256
LRU_BLOCKS = 4
LRU_BLOCK_WIDTH = LRU_WIDTH // LRU_BLOCKS
LRU_CONV = 4
LRU_C = 8.0

RET_HEADS = 4
RET_DK = 64
RET_DV = 64
RET_CHUNK = 128
ROPE_BASE = 10000.0

BRANCH_WIDTH = 256

IN_SPLITS = (
    GDN_HEADS * (2 * GDN_DK + GDN_DV),
    GDN_HEADS * GDN_DV,
    GDN_HEADS,
    GDN_HEADS,
    S5_WIDTH,
    LRU_WIDTH,
    LRU_WIDTH,
    RET_HEADS * RET_DK,
    RET_HEADS * RET_DK,
    RET_HEADS * RET_DV,
    RET_HEADS * RET_DV,
    N_BRANCH * D_MODEL,
)
N_IN = sum(IN_SPLITS)

kernel_name = "hybrid_gdn_s5_rglru_retnet_macaron"

F32 = jnp.float32


def rms_norm(x, w, eps=NORM_EPS):
    x32 = x.astype(F32)
    y = x32 * lax.rsqrt(jnp.mean(x32 * x32, axis=-1, keepdims=True) + eps)
    return (y * w.astype(F32)).astype(x.dtype)


def swiglu(x, w_gate, w_up, w_down):
    return (jax.nn.silu(x @ w_gate) * (x @ w_up)) @ w_down


def causal_dwconv(x, w):
    k = w.shape[0]
    return lax.conv_general_dilated(
        x, w[:, None, :].astype(x.dtype), window_strides=(1,), padding=[(k - 1, 0)],
        dimension_numbers=("NWC", "WIO", "NWC"), feature_group_count=x.shape[-1])


def l2norm(x, eps=1e-6):
    return x * lax.rsqrt(jnp.sum(x * x, axis=-1, keepdims=True) + eps)


def to_chunks(t, c):
    b, s, h, d = t.shape
    return t.reshape(b, s // c, c, h, d).transpose(0, 3, 1, 2, 4)


def from_chunks(t):
    b, h, n, c, d = t.shape
    return t.transpose(0, 2, 3, 1, 4).reshape(b, n * c, h, d)


def apply_rope(x, positions):
    half = x.shape[-1] // 2
    freqs = jnp.power(ROPE_BASE, -jnp.arange(half, dtype=F32) / half)
    ang = positions.astype(F32)[..., None] * freqs
    cos = jnp.cos(ang)[:, :, None, :]
    sin = jnp.sin(ang)[:, :, None, :]
    x1, x2 = x[..., :half], x[..., half:]
    return jnp.concatenate([x1 * cos - x2 * sin, x1 * sin + x2 * cos], axis=-1)


def gated_deltanet(qkv, z, beta_logit, a_logit, conv_w, a_log, dt_bias, norm_w):
    b, s, _ = qkv.shape
    dtype = qkv.dtype
    h, dk, dv, c = GDN_HEADS, GDN_DK, GDN_DV, GDN_CHUNK
    qkv = jax.nn.silu(causal_dwconv(qkv, conv_w)).astype(F32)
    q, k, v = jnp.split(qkv, [h * dk, 2 * h * dk], axis=-1)
    q = l2norm(q.reshape(b, s, h, dk)) * (dk ** -0.5)
    k = l2norm(k.reshape(b, s, h, dk))
    v = v.reshape(b, s, h, dv)
    beta = jax.nn.sigmoid(beta_logit.astype(F32))
    g = -jnp.exp(a_log.astype(F32)) * jax.nn.softplus(a_logit.astype(F32) + dt_bias.astype(F32))
    q, k, v = to_chunks(q, c), to_chunks(k, c), to_chunks(v, c)
    beta = to_chunks(beta[..., None], c)[..., 0]
    gc = jnp.cumsum(to_chunks(g[..., None], c)[..., 0], axis=-1)
    incl = jnp.tril(jnp.ones((c, c), dtype=bool))
    strict = jnp.tril(jnp.ones((c, c), dtype=bool), -1)
    diff = gc[..., :, None] - gc[..., None, :]
    decay = jnp.where(incl, jnp.exp(jnp.where(incl, diff, 0.0)), 0.0)
    kk = jnp.einsum("bhncd,bhnmd->bhncm", k, k)
    lower = jnp.where(strict, beta[..., None] * kk * decay, 0.0)
    rhs = jnp.concatenate([v * beta[..., None], k * (beta * jnp.exp(gc))[..., None]], axis=-1)
    sol = lax.linalg.triangular_solve(lower, rhs, left_side=True, lower=True, unit_diagonal=True)
    u, w = sol[..., :dv], sol[..., dv:]
    attn = jnp.einsum("bhncd,bhnmd->bhncm", q, k) * decay
    q_dec = q * jnp.exp(gc)[..., None]
    k_dec = k * jnp.exp(gc[..., -1:] - gc)[..., None]
    chunk_decay = jnp.exp(gc[..., -1])

    def step(state, xs):
        u_n, w_n, attn_n, q_n, k_n, dec_n = xs
        v_new = u_n - jnp.einsum("bhcd,bhde->bhce", w_n, state)
        o = jnp.einsum("bhcd,bhde->bhce", q_n, state) + jnp.einsum("bhcm,bhme->bhce", attn_n, v_new)
        state = state * dec_n[..., None, None] + jnp.einsum("bhcd,bhce->bhde", k_n, v_new)
        return state, o

    xs = tuple(jnp.moveaxis(t, 2, 0) for t in (u, w, attn, q_dec, k_dec, chunk_decay))
    _, o = lax.scan(step, jnp.zeros((b, h, dk, dv), F32), xs)
    o = from_chunks(jnp.moveaxis(o, 0, 2))
    o = rms_norm(o, norm_w) * jax.nn.silu(z.astype(F32).reshape(b, s, h, dv))
    return o.reshape(b, s, h * dv).astype(dtype)


def s5_layer(u, lam_re, lam_im, b_re, b_im, c_re, c_im, d, log_dt, w_glu, b_glu):
    bsz, s, _ = u.shape
    dtype = u.dtype
    gsz, gw, p = S5_GROUPS, S5_GROUP_WIDTH, S5_STATE
    u32 = u.astype(F32).reshape(bsz, s, gsz, gw)
    dt = jnp.exp(log_dt.astype(F32))[:, None]
    lr, li = lam_re.astype(F32), lam_im.astype(F32)
    mag = jnp.exp(lr * dt)
    abar_re, abar_im = mag * jnp.cos(li * dt), mag * jnp.sin(li * dt)
    den = lr * lr + li * li
    nr = abar_re - 1.0
    coef_re = (nr * lr + abar_im * li) / den
    coef_im = (abar_im * lr - nr * li) / den
    br, bi = b_re.astype(F32), b_im.astype(F32)
    bbar_re = coef_re[..., None] * br - coef_im[..., None] * bi
    bbar_im = coef_re[..., None] * bi + coef_im[..., None] * br
    bu_re = jnp.einsum("gpc,bsgc->bsgp", bbar_re, u32)
    bu_im = jnp.einsum("gpc,bsgc->bsgp", bbar_im, u32)
    a_re = jnp.broadcast_to(abar_re, (1, s, gsz, p))
    a_im = jnp.broadcast_to(abar_im, (1, s, gsz, p))

    def combine(e1, e2):
        a1r, a1i, b1r, b1i = e1
        a2r, a2i, b2r, b2i = e2
        return (a2r * a1r - a2i * a1i, a2r * a1i + a2i * a1r,
                a2r * b1r - a2i * b1i + b2r, a2r * b1i + a2i * b1r + b2i)

    _, _, x_re, x_im = lax.associative_scan(combine, (a_re, a_im, bu_re, bu_im), axis=1)
    y = (jnp.einsum("gcp,bsgp->bsgc", c_re.astype(F32), x_re)
         - jnp.einsum("gcp,bsgp->bsgc", c_im.astype(F32), x_im)
         + d.astype(F32) * u32)
    y = jax.nn.gelu(y.reshape(bsz, s, S5_WIDTH))
    y = y * jax.nn.sigmoid(y @ w_glu.astype(F32) + b_glu.astype(F32))
    return y.astype(dtype)


def rg_lru_block(xb, yb, conv_w, conv_b, w_a, b_a, w_i, b_i, lam):
    bsz, s, _ = xb.shape
    dtype = xb.dtype
    xc = (causal_dwconv(xb, conv_w) + conv_b).astype(F32)
    xblk = xc.reshape(bsz, s, LRU_BLOCKS, LRU_BLOCK_WIDTH)
    r = jax.nn.sigmoid(jnp.einsum("bsnc,ncd->bsnd", xblk, w_a.astype(F32)).reshape(bsz, s, LRU_WIDTH) + b_a.astype(F32))
    i = jax.nn.sigmoid(jnp.einsum("bsnc,ncd->bsnd", xblk, w_i.astype(F32)).reshape(bsz, s, LRU_WIDTH) + b_i.astype(F32))
    log_a = -LRU_C * r * jax.nn.softplus(-lam.astype(F32))
    a = jnp.exp(log_a)
    mult = jnp.sqrt(-jnp.expm1(2.0 * log_a))
    gated_x = xc * i * mult

    def step(h, inp):
        a_t, x_t = inp
        h = a_t * h + x_t
        return h, h

    _, hs = lax.scan(step, jnp.zeros((bsz, LRU_WIDTH), F32), (jnp.swapaxes(a, 0, 1), jnp.swapaxes(gated_x, 0, 1)))
    h = jnp.swapaxes(hs, 0, 1)
    return (h * jax.nn.gelu(yb.astype(F32))).astype(dtype)


def retention(q, k, v, g, positions, norm_w):
    bsz, s, _ = q.shape
    dtype = q.dtype
    h, dk, dv, c = RET_HEADS, RET_DK, RET_DV, RET_CHUNK
    q = apply_rope(q.astype(F32).reshape(bsz, s, h, dk), positions)
    k = apply_rope(k.astype(F32).reshape(bsz, s, h, dk), positions) * (dk ** -0.5)
    v = v.astype(F32).reshape(bsz, s, h, dv)
    log_gamma = jnp.log1p(-jnp.exp2(-5.0 - jnp.arange(h, dtype=F32)))
    idx = jnp.arange(c, dtype=F32)
    rel = idx[:, None] - idx[None, :]
    causal = rel >= 0
    intra = jnp.where(causal, jnp.exp(jnp.where(causal, rel, 0.0)[None] * log_gamma[:, None, None]), 0.0)
    qc, kc, vc = to_chunks(q, c), to_chunks(k, c), to_chunks(v, c)
    scores = jnp.einsum("bhncd,bhnmd->bhncm", qc, kc) * intra[None, :, None]
    o = jnp.einsum("bhncm,bhnme->bhnce", scores, vc)
    zeta = jnp.exp((c - 1.0 - idx)[None] * log_gamma[:, None])
    xi = jnp.exp((idx + 1.0)[None] * log_gamma[:, None])
    chunk_decay = jnp.exp(c * log_gamma)
    kv = jnp.einsum("bhncd,bhnce->bhnde", kc * zeta[None, :, None, :, None], vc)

    def step(state, kv_n):
        return state * chunk_decay[None, :, None, None] + kv_n, state

    _, prev = lax.scan(step, jnp.zeros((bsz, h, dk, dv), F32), jnp.moveaxis(kv, 2, 0))
    prev = jnp.moveaxis(prev, 0, 2)
    o = o + jnp.einsum("bhncd,bhnde->bhnce", qc, prev) * xi[None, :, None, :, None]
    o = from_chunks(o)
    mu = jnp.mean(o, axis=-1, keepdims=True)
    var = jnp.mean(jnp.square(o - mu), axis=-1, keepdims=True)
    on = ((o - mu) * lax.rsqrt(var + NORM_EPS)).reshape(bsz, s, h * dv) * norm_w.astype(F32)
    return (jax.nn.silu(g.astype(F32)) * on).astype(dtype)


def split_in(proj):
    offs, acc = [], 0
    for n in IN_SPLITS[:-1]:
        acc += n
        offs.append(acc)
    return jnp.split(proj, offs, axis=-1)


def hybrid_mixer(hn, positions, w_in, gdn_conv_w, gdn_a_log, gdn_dt_bias, gdn_norm_w,
                 s5_lambda_re, s5_lambda_im, s5_b_re, s5_b_im, s5_c_re, s5_c_im, s5_d, s5_log_dt,
                 s5_w_glu, s5_b_glu, lru_conv_w, lru_conv_b, lru_w_a, lru_b_a, lru_w_i, lru_b_i,
                 lru_lambda, ret_norm_w, w_branch, w_out):
    bsz, s, _ = hn.shape
    proj = hn @ w_in
    (gdn_qkv, gdn_z, gdn_b, gdn_a, s5_u, lru_x, lru_y,
     ret_q, ret_k, ret_v, ret_g, gate_logits) = split_in(proj)
    out_a = gated_deltanet(gdn_qkv, gdn_z, gdn_b, gdn_a, gdn_conv_w, gdn_a_log, gdn_dt_bias, gdn_norm_w)
    out_b = s5_layer(s5_u, s5_lambda_re, s5_lambda_im, s5_b_re, s5_b_im, s5_c_re, s5_c_im,
                     s5_d, s5_log_dt, s5_w_glu, s5_b_glu)
    out_c = rg_lru_block(lru_x, lru_y, lru_conv_w, lru_conv_b, lru_w_a, lru_b_a, lru_w_i, lru_b_i, lru_lambda)
    out_d = retention(ret_q, ret_k, ret_v, ret_g, positions, ret_norm_w)
    branches = jnp.stack([out_a, out_b, out_c, out_d], axis=2)
    gates = jax.nn.sigmoid(gate_logits.reshape(bsz, s, N_BRANCH, D_MODEL))
    merged = jnp.sum(gates * jnp.einsum("bsnc,ncd->bsnd", branches, w_branch), axis=2)
    return merged @ w_out


def setup_inputs(seed: int = 0) -> dict:
    key = jax.random.key(seed)
    ks = iter(jax.random.split(key, 48))
    L = DEPTH

    def nrm(shape, scale):
        return jax.random.normal(next(ks), shape, F32) * scale

    def unif(shape, lo, hi):
        return jax.random.uniform(next(ks), shape, F32, lo, hi)

    x = jax.random.normal(next(ks), (BATCH, SEQ, D_MODEL), F32)
    positions = jnp.broadcast_to(jnp.arange(SEQ, dtype=jnp.int32), (BATCH, SEQ))
    gdn_dt = jnp.exp(unif((L, GDN_HEADS), math.log(1e-3), math.log(1e-1)))
    lru_a0 = unif((L, LRU_WIDTH), 0.9, 0.999) ** (1.0 / LRU_C)
    return {
        "x": x,
        "positions": positions,
        "ffn1_norm": 1.0 + nrm((L, D_MODEL), 0.02),
        "ffn1_w_gate": nrm((L, D_MODEL, D_FF), D_MODEL ** -0.5),
        "ffn1_w_up": nrm((L, D_MODEL, D_FF), D_MODEL ** -0.5),
        "ffn1_w_down": nrm((L, D_FF, D_MODEL), D_FF ** -0.5),
        "mix_norm": 1.0 + nrm((L, D_MODEL), 0.02),
        "w_in": nrm((L, D_MODEL, N_IN), D_MODEL ** -0.5),
        "gdn_conv_w": nrm((L, GDN_CONV, GDN_HEADS * (2 * GDN_DK + GDN_DV)), GDN_CONV ** -0.5),
        "gdn_a_log": jnp.log(unif((L, GDN_HEADS), 1.0, 16.0)),
        "gdn_dt_bias": gdn_dt + jnp.log(-jnp.expm1(-gdn_dt)),
        "gdn_norm_w": 1.0 + nrm((L, GDN_DV), 0.02),
        "s5_lambda_re": -0.5 + nrm((L, S5_GROUPS, S5_STATE), 0.01),
        "s5_lambda_im": jnp.pi * jnp.arange(S5_STATE, dtype=F32) + nrm((L, S5_GROUPS, S5_STATE), 0.01),
        "s5_b_re": nrm((L, S5_GROUPS, S5_STATE, S5_GROUP_WIDTH), (2.0 * S5_GROUP_WIDTH) ** -0.5),
        "s5_b_im": nrm((L, S5_GROUPS, S5_STATE, S5_GROUP_WIDTH), (2.0 * S5_GROUP_WIDTH) ** -0.5),
        "s5_c_re": nrm((L, S5_GROUPS, S5_GROUP_WIDTH, S5_STATE), S5_STATE ** -0.5),
        "s5_c_im": nrm((L, S5_GROUPS, S5_GROUP_WIDTH, S5_STATE), S5_STATE ** -0.5),
        "s5_d": nrm((L, S5_GROUPS, S5_GROUP_WIDTH), 1.0),
        "s5_log_dt": unif((L, S5_GROUPS), math.log(1e-3), math.log(1e-1)),
        "s5_w_glu": nrm((L, S5_WIDTH, S5_WIDTH), S5_WIDTH ** -0.5),
        "s5_b_glu": nrm((L, S5_WIDTH), 0.01),
        "lru_conv_w": nrm((L, LRU_CONV, LRU_WIDTH), LRU_CONV ** -0.5),
        "lru_conv_b": nrm((L, LRU_WIDTH), 0.01),
        "lru_w_a": nrm((L, LRU_BLOCKS, LRU_BLOCK_WIDTH, LRU_BLOCK_WIDTH), LRU_BLOCK_WIDTH ** -0.5),
        "lru_b_a": nrm((L, LRU_WIDTH), 0.01),
        "lru_w_i": nrm((L, LRU_BLOCKS, LRU_BLOCK_WIDTH, LRU_BLOCK_WIDTH), LRU_BLOCK_WIDTH ** -0.5),
        "lru_b_i": nrm((L, LRU_WIDTH), 0.01),
        "lru_lambda": jnp.log(lru_a0) - jnp.log1p(-lru_a0),
        "ret_norm_w": 1.0 + nrm((L, RET_HEADS * RET_DV), 0.02),
        "w_branch": nrm((L, N_BRANCH, BRANCH_WIDTH, D_MODEL), BRANCH_WIDTH ** -0.5),
        "w_out": nrm((L, D_MODEL, D_MODEL), D_MODEL ** -0.5),
        "ffn2_norm": 1.0 + nrm((L, D_MODEL), 0.02),
        "ffn2_w_gate": nrm((L, D_MODEL, D_FF), D_MODEL ** -0.5),
        "ffn2_w_up": nrm((L, D_MODEL, D_FF), D_MODEL ** -0.5),
        "ffn2_w_down": nrm((L, D_FF, D_MODEL), D_FF ** -0.5),
        "final_norm": 1.0 + nrm((D_MODEL,), 0.02),
    }


def reference(x, positions, ffn1_norm, ffn1_w_gate, ffn1_w_up, ffn1_w_down, mix_norm, w_in,
              gdn_conv_w, gdn_a_log, gdn_dt_bias, gdn_norm_w,
              s5_lambda_re, s5_lambda_im, s5_b_re, s5_b_im, s5_c_re, s5_c_im, s5_d, s5_log_dt,
              s5_w_glu, s5_b_glu, lru_conv_w, lru_conv_b, lru_w_a, lru_b_a, lru_w_i, lru_b_i,
              lru_lambda, ret_norm_w, w_branch, w_out,
              ffn2_norm, ffn2_w_gate, ffn2_w_up, ffn2_w_down, final_norm):
    for l in range(DEPTH):
        x = x + 0.5 * swiglu(rms_norm(x, ffn1_norm[l]), ffn1_w_gate[l], ffn1_w_up[l], ffn1_w_down[l])
        x = x + hybrid_mixer(
            rms_norm(x, mix_norm[l]), positions, w_in[l],
            gdn_conv_w[l], gdn_a_log[l], gdn_dt_bias[l], gdn_norm_w[l],
            s5_lambda_re[l], s5_lambda_im[l], s5_b_re[l], s5_b_im[l], s5_c_re[l], s5_c_im[l],
            s5_d[l], s5_log_dt[l], s5_w_glu[l], s5_b_glu[l],
            lru_conv_w[l], lru_conv_b[l], lru_w_a[l], lru_b_a[l], lru_w_i[l], lru_b_i[l], lru_lambda[l],
            ret_norm_w[l], w_branch[l], w_out[l])
        x = x + 0.5 * swiglu(rms_norm(x, ffn2_norm[l]), ffn2_w_gate[l], ffn2_w_up[l], ffn2_w_down[l])
    return rms_norm(x, final_norm)
```

```cpp
#include <hip/hip_runtime.h>
#include <hip/hip_cooperative_groups.h>
#include <cstdio>
namespace cg = cooperative_groups;

typedef unsigned short bf16_t;
typedef short bf16x8 __attribute__((ext_vector_type(8)));
typedef float f32x16 __attribute__((ext_vector_type(16)));
typedef float f32x4 __attribute__((ext_vector_type(4)));
typedef float f32x2 __attribute__((ext_vector_type(2)));
typedef unsigned u32x4 __attribute__((ext_vector_type(4)));
typedef unsigned u32x2 __attribute__((ext_vector_type(2)));
#define DI __device__ __forceinline__

constexpr int T = 32768, D = 1024, FF = 2816, SEQ = 4096, NB = 8, DEPTH = 4;
constexpr int NIN = 6920, PW = 2816;
constexpr int NTHR = 512;
constexpr int LDS_BYTES = 147456;
constexpr float EPS = 1e-6f;
constexpr int PC_QKV = 0, PC_Z = 768, PC_S5 = 1024, PC_LX = 1280, PC_LY = 1536, PC_RQ = 1792, PC_RK = 2048, PC_RV = 2304, PC_RG = 2560;

constexpr size_t al256(size_t x) { return (x + 255) & ~(size_t)255; }
constexpr size_t WS_WGU1 = 0;
constexpr size_t WS_WD1 = WS_WGU1 + (size_t)2 * FF * D * 2;
constexpr size_t WS_WGU2 = WS_WD1 + (size_t)D * FF * 2;
constexpr size_t WS_WD2 = WS_WGU2 + (size_t)2 * FF * D * 2;
constexpr size_t WS_WIN = WS_WD2 + (size_t)D * FF * 2;
constexpr size_t WS_WGATE = WS_WIN + (size_t)PW * D * 2;
constexpr size_t WS_WBR = WS_WGATE + (size_t)4096 * D * 2;
constexpr size_t WS_WOUT = WS_WBR + (size_t)4 * D * 256 * 2;
constexpr size_t WS_WGLU = WS_WOUT + (size_t)D * D * 2;
constexpr size_t WS_XN = WS_WGLU + (size_t)256 * 256 * 2;
constexpr size_t WS_R = WS_XN + (size_t)T * D * 2;
constexpr size_t WS_BR = WS_R + (size_t)T * PW * 2;
constexpr size_t WS_EXT = WS_BR + (size_t)T * D * 2;
constexpr size_t WS_GMN = WS_EXT + (size_t)T * 8 * 4;
constexpr size_t WS_RKV = WS_GMN + (size_t)2048 * 8192 * 4;
constexpr size_t WS_S5ST = WS_RKV + (size_t)2048 * 4096 * 4;
constexpr size_t WS_LRUST = WS_S5ST + (size_t)NB * 64 * 1024 * 8;
constexpr size_t WS_YGL = WS_LRUST + (size_t)NB * 128 * 256 * 8;
constexpr size_t WS_END = WS_YGL + (size_t)T * 256 * 2;

struct Params { const float* in[37]; float* out; char* ws; };

DI bf16_t f2bf(float f) { unsigned u = __float_as_uint(f); u += 0x7fffu + ((u >> 16) & 1u); return (bf16_t)(u >> 16); }
DI float bf2f(bf16_t b) { return __uint_as_float(((unsigned)b) << 16); }
DI unsigned pack2(float lo, float hi) { return (unsigned)f2bf(lo) | ((unsigned)f2bf(hi) << 16); }
DI float sigmoidf_(float x) { return 1.f / (1.f + __expf(-x)); }
DI float siluf_(float x) { return x * sigmoidf_(x); }
DI float softplusf_(float x) { return x > 20.f ? x : log1pf(expf(x)); }
DI float geluf_(float x) { return 0.5f * x * (1.f + tanhf(0.7978845608028654f * (x + 0.044715f * x * x * x))); }
DI float wave_sum(float v) {
#pragma unroll
    for (int o = 1; o < 64; o <<= 1) v += __shfl_xor(v, o);
    return v;
}
DI int otid() { int t = threadIdx.x; asm volatile("" : "+v"(t)); return t; }
DI int crow(int i, int h) { return (i & 3) + 8 * (i >> 2) + 4 * h; }
#define MFMA32(a, b, c) __builtin_amdgcn_mfma_f32_32x32x16_bf16((a), (b), (c), 0, 0, 0)
#define MFMA16(a, b, c) __builtin_amdgcn_mfma_f32_16x16x32_bf16((a), (b), (c), 0, 0, 0)

DI f32x16 mma32(const bf16_t* A, const bf16_t* B, int K, f32x16 acc, int lane) {
    const int r = lane & 31, hh = lane >> 5;
    for (int k0 = 0; k0 < K; k0 += 16) {
        bf16x8 a = *(const bf16x8*)(A + r * 72 + k0 + 8 * hh);
        bf16x8 b = *(const bf16x8*)(B + r * 72 + k0 + 8 * hh);
        acc = MFMA32(a, b, acc);
    }
    return acc;
}
DI f32x16 zero16() { f32x16 z;
#pragma unroll
    for (int i = 0; i < 16; ++i) z[i] = 0.f;
    return z; }

template <int NS>
DI void gemm_tile(char* lds, const bf16_t* A, int lda, const bf16_t* Bt, int ldb, int K, int row0, int col0, f32x16 (&acc)[2][NS]) {
    constexpr int ASZ = 128 * 72 * 2, BSZ = 128 * NS * 72 * 2, STG = ASZ + BSZ;
    const int tid = otid(), lane = tid & 63, wid = tid >> 6, wr = wid >> 2, wc = wid & 3, r = lane & 31, hh = lane >> 5;
    u32x4 ra[2], rb[2 * NS];
    const int prow = tid >> 3, pk = (tid & 7) * 8;
    const bf16_t* Ag = A + (size_t)(row0 + prow) * lda + pk;
    const bf16_t* Bg = Bt + (size_t)(col0 + prow) * ldb + pk;
    const int nk = K / 64;
#pragma unroll
    for (int i = 0; i < 2; ++i) ra[i] = *(const u32x4*)(Ag + (size_t)(64 * i) * lda);
#pragma unroll
    for (int i = 0; i < 2 * NS; ++i) rb[i] = *(const u32x4*)(Bg + (size_t)(64 * i) * ldb);
    {
        char* sa = lds; char* sb = lds + ASZ;
#pragma unroll
        for (int i = 0; i < 2; ++i) *(u32x4*)(sa + ((prow + 64 * i) * 72 + pk) * 2) = ra[i];
#pragma unroll
        for (int i = 0; i < 2 * NS; ++i) *(u32x4*)(sb + ((prow + 64 * i) * 72 + pk) * 2) = rb[i];
    }
    __syncthreads();
    for (int kt = 0; kt < nk; ++kt) {
        const bool more = (kt + 1 < nk);
        if (more) {
#pragma unroll
            for (int i = 0; i < 2; ++i) ra[i] = *(const u32x4*)(Ag + (size_t)(64 * i) * lda + (kt + 1) * 64);
#pragma unroll
            for (int i = 0; i < 2 * NS; ++i) rb[i] = *(const u32x4*)(Bg + (size_t)(64 * i) * ldb + (kt + 1) * 64);
        }
        const char* sa = lds + (kt & 1) * STG; const char* sb = sa + ASZ;
        const bf16_t* pa = (const bf16_t*)sa + (wr * 64 + r) * 72 + 8 * hh;
        const bf16_t* pb = (const bf16_t*)sb + (wc * 32 * NS + r) * 72 + 8 * hh;
#pragma unroll
        for (int ks = 0; ks < 4; ++ks) {
            bf16x8 a0 = *(const bf16x8*)(pa + ks * 16), a1 = *(const bf16x8*)(pa + 32 * 72 + ks * 16);
#pragma unroll
            for (int ni = 0; ni < NS; ++ni) {
                bf16x8 b = *(const bf16x8*)(pb + ni * 32 * 72 + ks * 16);
                acc[0][ni] = MFMA32(a0, b, acc[0][ni]);
                acc[1][ni] = MFMA32(a1, b, acc[1][ni]);
            }
        }
        if (more) {
            char* sa2 = lds + ((kt + 1) & 1) * STG; char* sb2 = sa2 + ASZ;
#pragma unroll
            for (int i = 0; i < 2; ++i) *(u32x4*)(sa2 + ((prow + 64 * i) * 72 + pk) * 2) = ra[i];
#pragma unroll
            for (int i = 0; i < 2 * NS; ++i) *(u32x4*)(sb2 + ((prow + 64 * i) * 72 + pk) * 2) = rb[i];
        }
        __syncthreads();
    }
}

DI void wconv_tile(const float* src0, const float* src1, int ld, int mode, int c0, int K, bf16_t* dst, int tile, float* tl) {
    const int nkt = K / 64, tr = tile / nkt, tk = tile % nkt, R0 = tr * 64, k0 = tk * 64, tid = otid();
    {
        const int rl = tid & 63, kq = tid >> 6, R = R0 + rl;
        const float* src = src0; int col;
        if (mode == 0) col = R + c0;
        else if (mode == 1) { if ((R & 63) >= 32) src = src1; col = (R >> 6) * 32 + (R & 31); }
        else col = R < 1024 ? R : R + 8;
#pragma unroll
        for (int i = 0; i < 8; ++i) { const int k = kq + 8 * i; tl[k * 65 + rl] = src[(size_t)(k0 + k) * ld + col]; }
    }
    __syncthreads();
    {
        const int kp = tid & 31, rr = tid >> 5;
#pragma unroll
        for (int i = 0; i < 4; ++i) { const int R = rr + 16 * i;
            *(unsigned*)(dst + (size_t)(R0 + R) * K + k0 + 2 * kp) = pack2(tl[(2 * kp) * 65 + R], tl[(2 * kp + 1) * 65 + R]); }
    }
    __syncthreads();
}
DI void phase_wconv(const Params& p, int l, char* lds) {
    float* tl = (float*)lds;
    const float* g1 = p.in[3] + (size_t)l * D * FF; const float* u1 = p.in[4] + (size_t)l * D * FF; const float* d1 = p.in[5] + (size_t)l * FF * D;
    const float* g2 = p.in[33] + (size_t)l * D * FF; const float* u2 = p.in[34] + (size_t)l * D * FF; const float* d2 = p.in[35] + (size_t)l * FF * D;
    const float* win = p.in[7] + (size_t)l * D * NIN; const float* wbr = p.in[30] + (size_t)l * 4 * 256 * D; const float* wout = p.in[31] + (size_t)l * D * D;
    const float* wglu = p.in[20] + (size_t)l * 65536;
    constexpr int I_GU = 88 * 16, I_D = 16 * 44, I_IN = 44 * 16, I_GATE = 64 * 16, I_BR = 16 * 4, I_OUT = 16 * 16, I_GLU = 16;
    constexpr int TOTAL = 2 * I_GU + 2 * I_D + I_IN + I_GATE + 4 * I_BR + I_OUT + I_GLU;
    for (int it = blockIdx.x; it < TOTAL; it += gridDim.x) {
        int r = it;
        if (r < I_GU) { wconv_tile(g1, u1, FF, 1, 0, D, (bf16_t*)(p.ws + WS_WGU1), r, tl); continue; } r -= I_GU;
        if (r < I_GU) { wconv_tile(g2, u2, FF, 1, 0, D, (bf16_t*)(p.ws + WS_WGU2), r, tl); continue; } r -= I_GU;
        if (r < I_D) { wconv_tile(d1, d1, D, 0, 0, FF, (bf16_t*)(p.ws + WS_WD1), r, tl); continue; } r -= I_D;
        if (r < I_D) { wconv_tile(d2, d2, D, 0, 0, FF, (bf16_t*)(p.ws + WS_WD2), r, tl); continue; } r -= I_D;
        if (r < I_IN) { wconv_tile(win, win, NIN, 2, 0, D, (bf16_t*)(p.ws + WS_WIN), r, tl); continue; } r -= I_IN;
        if (r < I_GATE) { wconv_tile(win, win, NIN, 0, 2824, D, (bf16_t*)(p.ws + WS_WGATE), r, tl); continue; } r -= I_GATE;
        if (r < 4 * I_BR) { const int n = r / I_BR; wconv_tile(wbr + (size_t)n * 256 * D, wbr, D, 0, 0, 256, (bf16_t*)(p.ws + WS_WBR) + (size_t)n * D * 256, r % I_BR, tl); continue; } r -= 4 * I_BR;
        if (r < I_OUT) { wconv_tile(wout, wout, D, 0, 0, D, (bf16_t*)(p.ws + WS_WOUT), r, tl); continue; } r -= I_OUT;
        wconv_tile(wglu, wglu, 256, 0, 0, 256, (bf16_t*)(p.ws + WS_WGLU), r, tl);
    }
}

template <bool EXT>
DI void phase_norm(const Params& p, const float* x, const float* nw, const float* win_l, char* lds) {
    const int tid = otid(), lane = tid & 63, wid = tid >> 6;
    bf16_t* xn = (bf16_t*)(p.ws + WS_XN);
    float* ext = (float*)(p.ws + WS_EXT);
    float* wext = (float*)lds;
    if (EXT) {
        for (int idx = tid; idx < 8192; idx += NTHR) { const int k = idx >> 3, c = idx & 7; wext[c * 1024 + k] = nw[k] * win_l[(size_t)k * NIN + 1024 + c]; }
        __syncthreads();
    }
    f32x4 nv[4];
#pragma unroll
    for (int j = 0; j < 4; ++j) nv[j] = *(const f32x4*)(nw + 4 * lane + 256 * j);
    for (int row = blockIdx.x * 8 + wid; row < T; row += gridDim.x * 8) {
        const float* xr = x + (size_t)row * D;
        f32x4 v[4]; float s = 0.f;
#pragma unroll
        for (int j = 0; j < 4; ++j) { v[j] = *(const f32x4*)(xr + 4 * lane + 256 * j); s += v[j].x * v[j].x + v[j].y * v[j].y + v[j].z * v[j].z + v[j].w * v[j].w; }
        s = wave_sum(s);
        const float inv = rsqrtf(s * (1.f / D) + EPS);
#pragma unroll
        for (int j = 0; j < 4; ++j) {
            u32x2 o; o.x = pack2(v[j].x * inv * nv[j].x, v[j].y * inv * nv[j].y); o.y = pack2(v[j].z * inv * nv[j].z, v[j].w * inv * nv[j].w);
            *(u32x2*)(xn + (size_t)row * D + 4 * lane + 256 * j) = o;
        }
        if (EXT) {
            float e[8];
#pragma unroll
            for (int c = 0; c < 8; ++c) { float a = 0.f;
#pragma unroll
                for (int j = 0; j < 4; ++j) { const f32x4 w = *(const f32x4*)(wext + c * 1024 + 4 * lane + 256 * j); a += v[j].x * w.x + v[j].y * w.y + v[j].z * w.z + v[j].w * w.w; }
                e[c] = wave_sum(a) * inv; }
            if (lane == 0) { *(f32x4*)(ext + (size_t)row * 8) = (f32x4){e[0], e[1], e[2], e[3]}; *(f32x4*)(ext + (size_t)row * 8 + 4) = (f32x4){e[4], e[5], e[6], e[7]}; }
        }
    }
    if (EXT) __syncthreads();
}
DI void phase_final_norm(const Params& p, const float* nw) {
    const int tid = otid(), lane = tid & 63, wid = tid >> 6;
    f32x4 nv[4];
#pragma unroll
    for (int j = 0; j < 4; ++j) nv[j] = *(const f32x4*)(nw + 4 * lane + 256 * j);
    for (int row = blockIdx.x * 8 + wid; row < T; row += gridDim.x * 8) {
        float* xr = p.out + (size_t)row * D;
        f32x4 v[4]; float s = 0.f;
#pragma unroll
        for (int j = 0; j < 4; ++j) { v[j] = *(const f32x4*)(xr + 4 * lane + 256 * j); s += v[j].x * v[j].x + v[j].y * v[j].y + v[j].z * v[j].z + v[j].w * v[j].w; }
        s = wave_sum(s);
        const float inv = rsqrtf(s * (1.f / D) + EPS);
#pragma unroll
        for (int j = 0; j < 4; ++j) *(f32x4*)(xr + 4 * lane + 256 * j) = (f32x4){v[j].x * inv * nv[j].x, v[j].y * inv * nv[j].y, v[j].z * inv * nv[j].z, v[j].w * inv * nv[j].w};
    }
}

DI void phase_ffn_a(const Params& p, const bf16_t* wgu, char* lds) {
    const bf16_t* xn = (const bf16_t*)(p.ws + WS_XN); bf16_t* hbuf = (bf16_t*)(p.ws + WS_R);
    const int tid_ = otid(), lane = tid_ & 63, wid = tid_ >> 6, wr = wid >> 2, wc = wid & 3, r = lane & 31, hh = lane >> 5;
    constexpr int nN = 2 * FF / 256, total = (T / 128) * nN;
    for (int tile = blockIdx.x; tile < total; tile += gridDim.x) {
        const int pm = tile / nN, pn = tile % nN;
        f32x16 acc[2][2]; acc[0][0] = zero16(); acc[0][1] = zero16(); acc[1][0] = zero16(); acc[1][1] = zero16();
        gemm_tile<2>(lds, xn, D, wgu, D, D, pm * 128, pn * 256, acc);
        const int j = pn * 128 + wc * 32 + r;
#pragma unroll
        for (int mi = 0; mi < 2; ++mi)
#pragma unroll
            for (int i = 0; i < 16; ++i) { const int row = pm * 128 + wr * 64 + mi * 32 + crow(i, hh);
                hbuf[(size_t)row * FF + j] = f2bf(siluf_(acc[mi][0][i]) * acc[mi][1][i]); }
    }
}
DI void phase_gemm_res(const Params& p, const bf16_t* A, int K, const bf16_t* Wt, const float* xin, float scale, char* lds) {
    const int tid_ = otid(), lane = tid_ & 63, wid = tid_ >> 6, wr = wid >> 2, wc = wid & 3, r = lane & 31, hh = lane >> 5;
    constexpr int nN = D / 256, total = (T / 128) * nN;
    for (int tile = blockIdx.x; tile < total; tile += gridDim.x) {
        const int pm = tile / nN, pn = tile % nN;
        f32x16 acc[2][2]; acc[0][0] = zero16(); acc[0][1] = zero16(); acc[1][0] = zero16(); acc[1][1] = zero16();
        gemm_tile<2>(lds, A, K, Wt, K, K, pm * 128, pn * 256, acc);
#pragma unroll
        for (int mi = 0; mi < 2; ++mi)
#pragma unroll
            for (int ni = 0; ni < 2; ++ni)
#pragma unroll
                for (int i = 0; i < 16; ++i) { const size_t o = (size_t)(pm * 128 + wr * 64 + mi * 32 + crow(i, hh)) * D + pn * 256 + wc * 64 + ni * 32 + r;
                    p.out[o] = xin[o] + scale * acc[mi][ni][i]; }
    }
}
DI void phase_proj(const Params& p, char* lds) {
    const bf16_t* xn = (const bf16_t*)(p.ws + WS_XN); bf16_t* P = (bf16_t*)(p.ws + WS_R); const bf16_t* W = (const bf16_t*)(p.ws + WS_WIN);
    const int tid_ = otid(), lane = tid_ & 63, wid = tid_ >> 6, wr = wid >> 2, wc = wid & 3, r = lane & 31, hh = lane >> 5;
    constexpr int nN = PW / 256, total = (T / 128) * nN;
    for (int tile = blockIdx.x; tile < total; tile += gridDim.x) {
        const int pm = tile / nN, pn = tile % nN;
        f32x16 acc[2][2]; acc[0][0] = zero16(); acc[0][1] = zero16(); acc[1][0] = zero16(); acc[1][1] = zero16();
        gemm_tile<2>(lds, xn, D, W, D, D, pm * 128, pn * 256, acc);
#pragma unroll
        for (int mi = 0; mi < 2; ++mi)
#pragma unroll
            for (int ni = 0; ni < 2; ++ni)
#pragma unroll
                for (int i = 0; i < 16; ++i) P[(size_t)(pm * 128 + wr * 64 + mi * 32 + crow(i, hh)) * PW + pn * 256 + wc * 64 + ni * 32 + r] = f2bf(acc[mi][ni][i]);
    }
}
DI void phase_glu(const Params& p, const float* bglu, char* lds) {
    const bf16_t* Y = (const bf16_t*)(p.ws + WS_YGL); const bf16_t* W = (const bf16_t*)(p.ws + WS_WGLU); bf16_t* br = (bf16_t*)(p.ws + WS_BR);
    const int tid_ = otid(), lane = tid_ & 63, wid = tid_ >> 6, wr = wid >> 2, wc = wid & 3, r = lane & 31, hh = lane >> 5;
    for (int tile = blockIdx.x; tile < T / 128; tile += gridDim.x) {
        f32x16 acc[2][2]; acc[0][0] = zero16(); acc[0][1] = zero16(); acc[1][0] = zero16(); acc[1][1] = zero16();
        gemm_tile<2>(lds, Y, 256, W, 256, 256, tile * 128, 0, acc);
#pragma unroll
        for (int mi = 0; mi < 2; ++mi)
#pragma unroll
            for (int ni = 0; ni < 2; ++ni)
#pragma unroll
                for (int i = 0; i < 16; ++i) { const int row = tile * 128 + wr * 64 + mi * 32 + crow(i, hh), j = wc * 64 + ni * 32 + r;
                    const float y = bf2f(Y[(size_t)row * 256 + j]);
                    br[(size_t)row * D + 256 + j] = f2bf(y * sigmoidf_(acc[mi][ni][i] + bglu[j])); }
    }
}
DI void phase_merge(const Params& p, char* lds) {
    const bf16_t* xn = (const bf16_t*)(p.ws + WS_XN); const bf16_t* br = (const bf16_t*)(p.ws + WS_BR);
    const bf16_t* wg = (const bf16_t*)(p.ws + WS_WGATE); const bf16_t* wb = (const bf16_t*)(p.ws + WS_WBR); bf16_t* mg = (bf16_t*)(p.ws + WS_R);
    const int tid_ = otid(), lane = tid_ & 63, wid = tid_ >> 6, wr = wid >> 2, wc = wid & 3, r = lane & 31, hh = lane >> 5;
    constexpr int nN = D / 128, total = (T / 128) * nN;
    for (int tile = blockIdx.x; tile < total; tile += gridDim.x) {
        const int pm = tile / nN, pn = tile % nN;
        f32x16 mr[2]; mr[0] = zero16(); mr[1] = zero16();
#pragma unroll 1
        for (int n = 0; n < 4; ++n) {
            unsigned gp[2][8];
            {
                f32x16 ag[2][1]; ag[0][0] = zero16(); ag[1][0] = zero16();
                gemm_tile<1>(lds, xn, D, wg + (size_t)n * D * D, D, D, pm * 128, pn * 128, ag);
#pragma unroll
                for (int mi = 0; mi < 2; ++mi)
#pragma unroll
                    for (int i = 0; i < 8; ++i) gp[mi][i] = pack2(sigmoidf_(ag[mi][0][2 * i]), sigmoidf_(ag[mi][0][2 * i + 1]));
            }
            f32x16 ab[2][1]; ab[0][0] = zero16(); ab[1][0] = zero16();
            gemm_tile<1>(lds, br + n * 256, D, wb + (size_t)n * D * 256, 256, 256, pm * 128, pn * 128, ab);
#pragma unroll
            for (int mi = 0; mi < 2; ++mi)
#pragma unroll
                for (int i = 0; i < 8; ++i) { mr[mi][2 * i] += __uint_as_float(gp[mi][i] << 16) * ab[mi][0][2 * i]; mr[mi][2 * i + 1] += __uint_as_float(gp[mi][i] & 0xffff0000u) * ab[mi][0][2 * i + 1]; }
        }
#pragma unroll
        for (int mi = 0; mi < 2; ++mi)
#pragma unroll
            for (int i = 0; i < 16; ++i) mg[(size_t)(pm * 128 + wr * 64 + mi * 32 + crow(i, hh)) * D + pn * 128 + wc * 32 + r] = f2bf(mr[mi][i]);
    }
}

template <int MODE>
DI void gdn_item(const Params& p, int l, int item, char* lds) {
    const int tid = otid(), lane = tid & 63, wid = tid >> 6, r = lane & 31, hh = lane >> 5;
    const int bh = item >> 6, n = item & 63, b = bh >> 2, h = bh & 3;
    const int trow0 = b * SEQ + n * 64, s0 = n * 64;
    const bf16_t* P = (const bf16_t*)(p.ws + WS_R);
    const float* ext = (const float*)(p.ws + WS_EXT);
    float* gmn = (float*)(p.ws + WS_GMN) + (size_t)item * 8192;
    const float* cw = p.in[8] + (size_t)l * 4 * 768;
    float* fq = (float*)lds; float* fk = fq + 64 * 65; float* fv = fk + 64 * 65;
    float* Lf = (float*)lds;
    bf16_t* solT = (bf16_t*)(lds + 17408);
    bf16_t* wb = (bf16_t*)(lds + 17408);
    bf16_t* SbT = (bf16_t*)(lds + 26624);
    bf16_t* attnb = (bf16_t*)(lds + 35840);
    bf16_t* vnT = (bf16_t*)(lds + 45056);
    float* of = (float*)lds;
    bf16_t* qb = (bf16_t*)(lds + 54272); bf16_t* qdb = (bf16_t*)(lds + 63488); bf16_t* kb = (bf16_t*)(lds + 72704); bf16_t* kdT = (bf16_t*)(lds + 81920);
    float* rhs = (float*)(lds + 91136);
    float* gc = (float*)(lds + 123904); float* beta = gc + 64; float* qsc = gc + 128; float* ksc = gc + 192;
    for (int idx = tid; idx < 64 * 192; idx += NTHR) {
        const int t = idx / 192, c = idx % 192, which = c >> 6, d = c & 63, col = which * 256 + h * 64 + d;
        float a = 0.f;
#pragma unroll
        for (int k = 0; k < 4; ++k) { const int tt = t - 3 + k; if (s0 + tt >= 0) a += cw[k * 768 + col] * bf2f(P[(size_t)(trow0 + tt) * PW + PC_QKV + col]); }
        (which == 0 ? fq : (which == 1 ? fk : fv))[t * 65 + d] = siluf_(a);
    }
    __syncthreads();
    if (tid < 128) { const int t = tid & 63, w = tid >> 6; const float* f = w ? fk : fq; float s = 0.f;
        for (int d = 0; d < 64; ++d) { const float v = f[t * 65 + d]; s += v * v; }
        (w ? ksc : qsc)[t] = rsqrtf(s + 1e-6f) * (w ? 1.f : 0.125f);
    } else if (tid < 192) { const int t = tid - 128;
        beta[t] = sigmoidf_(ext[(size_t)(trow0 + t) * 8 + h]);
        gc[t] = -expf(p.in[9][l * 4 + h]) * softplusf_(ext[(size_t)(trow0 + t) * 8 + 4 + h] + p.in[10][l * 4 + h]);
    }
    __syncthreads();
    if (wid == 0) { float v = gc[lane];
#pragma unroll
        for (int o = 1; o < 64; o <<= 1) { const float u = __shfl_up(v, o); if (lane >= o) v += u; }
        gc[lane] = v; }
    __syncthreads();
    {
        const float gl = gc[63];
        for (int idx = tid; idx < 4096; idx += NTHR) { const int t = idx >> 6, d = idx & 63;
            const float g = gc[t], eg = expf(g), bt = beta[t];
            const float qv = fq[t * 65 + d] * qsc[t], kv = fk[t * 65 + d] * ksc[t], vv = fv[t * 65 + d];
            qb[t * 72 + d] = f2bf(qv); qdb[t * 72 + d] = f2bf(qv * eg); kb[t * 72 + d] = f2bf(kv); kdT[d * 72 + t] = f2bf(kv * expf(gl - g));
            rhs[t * 128 + d] = bt * vv; rhs[t * 128 + 64 + d] = bt * eg * kv; }
    }
    __syncthreads();
    if (wid < 4) { const int ti = wid >> 1, tj = wid & 1;
        f32x16 a = mma32(kb + ti * 32 * 72, kb + tj * 32 * 72, 64, zero16(), lane);
#pragma unroll
        for (int i = 0; i < 16; ++i) { const int c = ti * 32 + crow(i, hh), m = tj * 32 + r; Lf[c * 68 + m] = (m < c) ? beta[c] * a[i] * expf(gc[c] - gc[m]) : 0.f; }
    } else if (MODE == 3) { const int w = wid - 4, ti = w >> 1, tj = w & 1;
        f32x16 a = mma32(qb + ti * 32 * 72, kb + tj * 32 * 72, 64, zero16(), lane);
#pragma unroll
        for (int i = 0; i < 16; ++i) { const int c = ti * 32 + crow(i, hh), m = tj * 32 + r; attnb[c * 72 + m] = f2bf((m <= c) ? a[i] * expf(gc[c] - gc[m]) : 0.f); }
    }
    if (MODE == 3) for (int idx = tid; idx < 4096; idx += NTHR) { const int d = idx >> 6, e = idx & 63; SbT[e * 72 + d] = f2bf(gmn[4096 + idx]); }
    __syncthreads();
    if (tid < 128) { const int col = tid; float sol[64];
#pragma unroll
        for (int c = 0; c < 64; ++c) { float s = rhs[c * 128 + col];
#pragma unroll
            for (int m = 0; m < c; ++m) s -= Lf[c * 68 + m] * sol[m];
            sol[c] = s; }
#pragma unroll
        for (int c = 0; c < 64; ++c) rhs[c * 128 + col] = sol[c];
    }
    __syncthreads();
    if (MODE == 1) {
        for (int idx = tid; idx < 128 * 64; idx += NTHR) { const int col = idx >> 6, c = idx & 63; solT[col * 72 + c] = f2bf(rhs[c * 128 + col]); }
        __syncthreads();
        const int which = wid >> 2, ti = (wid >> 1) & 1, tj = wid & 1;
        f32x16 a = mma32(kdT + ti * 32 * 72, solT + ((which == 0 ? 64 : 0) + tj * 32) * 72, 64, zero16(), lane);
        const float egl = expf(gc[63]);
#pragma unroll
        for (int i = 0; i < 16; ++i) { const int d = ti * 32 + crow(i, hh), j = tj * 32 + r;
            if (which == 0) gmn[d * 64 + j] = (d == j ? egl : 0.f) - a[i]; else gmn[4096 + d * 64 + j] = a[i]; }
        __syncthreads();
    } else {
        for (int idx = tid; idx < 4096; idx += NTHR) { const int t = idx >> 6, j = idx & 63; wb[t * 72 + j] = f2bf(rhs[t * 128 + 64 + j]); }
        __syncthreads();
        if (wid < 4) { const int ti = wid >> 1, tj = wid & 1;
            f32x16 a = mma32(wb + ti * 32 * 72, SbT + tj * 32 * 72, 64, zero16(), lane);
#pragma unroll
            for (int i = 0; i < 16; ++i) { const int t = ti * 32 + crow(i, hh), e = tj * 32 + r; vnT[e * 72 + t] = f2bf(rhs[t * 128 + e] - a[i]); }
        }
        __syncthreads();
        if (wid < 4) { const int ti = wid >> 1, tj = wid & 1;
            f32x16 a = mma32(qdb + ti * 32 * 72, SbT + tj * 32 * 72, 64, zero16(), lane);
            a = mma32(attnb + ti * 32 * 72, vnT + tj * 32 * 72, 64, a, lane);
#pragma unroll
            for (int i = 0; i < 16; ++i) of[(ti * 32 + crow(i, hh)) * 65 + tj * 32 + r] = a[i];
        }
        __syncthreads();
        { const int t = tid >> 3, sub = tid & 7; float v[8], ss = 0.f;
#pragma unroll
            for (int q = 0; q < 8; ++q) { v[q] = of[t * 65 + sub * 8 + q]; ss += v[q] * v[q]; }
            ss += __shfl_xor(ss, 1); ss += __shfl_xor(ss, 2); ss += __shfl_xor(ss, 4);
            const float inv = rsqrtf(ss * (1.f / 64.f) + EPS);
            const bf16_t* zp = P + (size_t)(trow0 + t) * PW + PC_Z + h * 64 + sub * 8;
            const float* nw = p.in[11] + l * 64 + sub * 8;
            unsigned o[4];
#pragma unroll
            for (int q = 0; q < 4; ++q) o[q] = pack2(v[2 * q] * inv * nw[2 * q] * siluf_(bf2f(zp[2 * q])), v[2 * q + 1] * inv * nw[2 * q + 1] * siluf_(bf2f(zp[2 * q + 1])));
            *(u32x4*)((bf16_t*)(p.ws + WS_BR) + (size_t)(trow0 + t) * D + h * 64 + sub * 8) = (u32x4){o[0], o[1], o[2], o[3]};
        }
        __syncthreads();
    }
}

template <int MODE>
DI void ret_item(const Params& p, int l, int item, char* lds) {
    const int tid = otid(), lane = tid & 63, wid = tid >> 6, r = lane & 31, hh = lane >> 5;
    const int bh = item >> 6, n = item & 63, b = bh >> 2, h = bh & 3;
    const int trow0 = b * SEQ + n * 64;
    const bf16_t* P = (const bf16_t*)(p.ws + WS_R);
    const int* pos = (const int*)p.in[1];
    float* kvg = (float*)(p.ws + WS_RKV) + (size_t)item * 4096;
    bf16_t* qb = (bf16_t*)lds; bf16_t* kb = qb + 64 * 72; bf16_t* qxb = kb + 64 * 72; bf16_t* vT = qxb + 64 * 72; bf16_t* prevT = vT + 64 * 72; bf16_t* sb = prevT + 64 * 72; bf16_t* kzT = sb + 64 * 72;
    float* of = (float*)(lds + 7 * 9216);
    const float lg = log1pf(-exp2f(-5.f - (float)h));
    for (int idx = tid; idx < 64 * 32; idx += NTHR) { const int t = idx >> 5, i = idx & 31;
        const float freq = exp2f(-(float)i * (13.287712379549449f / 32.f));
        const float ang = (float)pos[trow0 + t] * freq; float sn, cs; sincosf(ang, &sn, &cs);
        const bf16_t* pr = P + (size_t)(trow0 + t) * PW;
        const float k1 = bf2f(pr[PC_RK + h * 64 + i]), k2 = bf2f(pr[PC_RK + h * 64 + 32 + i]);
        const float kr1 = (k1 * cs - k2 * sn) * 0.125f, kr2 = (k1 * sn + k2 * cs) * 0.125f;
        if (MODE == 1) { const float z = expf((63.f - (float)t) * lg); kzT[i * 72 + t] = f2bf(kr1 * z); kzT[(32 + i) * 72 + t] = f2bf(kr2 * z); }
        else { const float q1 = bf2f(pr[PC_RQ + h * 64 + i]), q2 = bf2f(pr[PC_RQ + h * 64 + 32 + i]);
            const float qr1 = q1 * cs - q2 * sn, qr2 = q1 * sn + q2 * cs, xi = expf(((float)t + 1.f) * lg);
            kb[t * 72 + i] = f2bf(kr1); kb[t * 72 + 32 + i] = f2bf(kr2);
            qb[t * 72 + i] = f2bf(qr1); qb[t * 72 + 32 + i] = f2bf(qr2);
            qxb[t * 72 + i] = f2bf(qr1 * xi); qxb[t * 72 + 32 + i] = f2bf(qr2 * xi); }
    }
    for (int idx = tid; idx < 4096; idx += NTHR) { const int t = idx >> 6, e = idx & 63; vT[e * 72 + t] = P[(size_t)(trow0 + t) * PW + PC_RV + h * 64 + e]; }
    if (MODE == 3) for (int idx = tid; idx < 4096; idx += NTHR) { const int d = idx >> 6, e = idx & 63; prevT[e * 72 + d] = f2bf(kvg[idx]); }
    __syncthreads();
    if (MODE == 1) {
        if (wid < 4) { const int ti = wid >> 1, tj = wid & 1;
            f32x16 a = mma32(kzT + ti * 32 * 72, vT + tj * 32 * 72, 64, zero16(), lane);
#pragma unroll
            for (int i = 0; i < 16; ++i) kvg[(ti * 32 + crow(i, hh)) * 64 + tj * 32 + r] = a[i];
        }
        __syncthreads();
    } else {
        if (wid < 4) { const int ti = wid >> 1, tj = wid & 1;
            f32x16 a = mma32(qb + ti * 32 * 72, kb + tj * 32 * 72, 64, zero16(), lane);
#pragma unroll
            for (int i = 0; i < 16; ++i) { const int c = ti * 32 + crow(i, hh), m = tj * 32 + r; sb[c * 72 + m] = f2bf((m <= c) ? a[i] * expf((float)(c - m) * lg) : 0.f); }
        }
        __syncthreads();
        if (wid < 4) { const int ti = wid >> 1, tj = wid & 1;
            f32x16 a = mma32(sb + ti * 32 * 72, vT + tj * 32 * 72, 64, zero16(), lane);
            a = mma32(qxb + ti * 32 * 72, prevT + tj * 32 * 72, 64, a, lane);
#pragma unroll
            for (int i = 0; i < 16; ++i) of[(ti * 32 + crow(i, hh)) * 65 + tj * 32 + r] = a[i];
        }
        __syncthreads();
        { const int t = tid >> 3, sub = tid & 7; float v[8], s1 = 0.f;
#pragma unroll
            for (int q = 0; q < 8; ++q) { v[q] = of[t * 65 + sub * 8 + q]; s1 += v[q]; }
            s1 += __shfl_xor(s1, 1); s1 += __shfl_xor(s1, 2); s1 += __shfl_xor(s1, 4);
            const float mu = s1 * (1.f / 64.f); float s2 = 0.f;
#pragma unroll
            for (int q = 0; q < 8; ++q) { v[q] -= mu; s2 += v[q] * v[q]; }
            s2 += __shfl_xor(s2, 1); s2 += __shfl_xor(s2, 2); s2 += __shfl_xor(s2, 4);
            const float inv = rsqrtf(s2 * (1.f / 64.f) + EPS);
            const bf16_t* gp = P + (size_t)(trow0 + t) * PW + PC_RG + h * 64 + sub * 8;
            const float* nw = p.in[29] + l * 256 + h * 64 + sub * 8;
            unsigned o[4];
#pragma unroll
            for (int q = 0; q < 4; ++q) o[q] = pack2(v[2 * q] * inv * nw[2 * q] * siluf_(bf2f(gp[2 * q])), v[2 * q + 1] * inv * nw[2 * q + 1] * siluf_(bf2f(gp[2 * q + 1])));
            *(u32x4*)((bf16_t*)(p.ws + WS_BR) + (size_t)(trow0 + t) * D + 768 + h * 64 + sub * 8) = (u32x4){o[0], o[1], o[2], o[3]};
        }
        __syncthreads();
    }
}

template <int MODE>
DI void s5_item(const Params& p, int l, int item, char* lds) {
    const int tid = otid(), lane = tid & 63, wid = tid >> 6;
    const int half = item & 1, bn = item >> 1, n = bn & 63, b = bn >> 6, g = half * 8 + wid, pp = lane;
    const int trow0 = b * SEQ + n * 64;
    const bf16_t* P = (const bf16_t*)(p.ws + WS_R);
    float* us = (float*)lds;
    bf16_t* Xw = (bf16_t*)(lds + 32768) + wid * 16 * 136;
    f32x2* st = (f32x2*)(p.ws + WS_S5ST) + (size_t)bn * 1024 + g * 64 + pp;
    const int gi = l * 16 + g;
    const float dt = expf(p.in[19][gi]);
    const float lr = p.in[12][gi * 64 + pp], li = p.in[13][gi * 64 + pp];
    const float mag = expf(lr * dt); float sn, cs; sincosf(li * dt, &sn, &cs);
    const float ar = mag * cs, ai = mag * sn, den = lr * lr + li * li, nr = ar - 1.f;
    const float cr = (nr * lr + ai * li) / den, ci = (ai * lr - nr * li) / den;
    float bbr[16], bbi[16];
    {
        const float* brp = p.in[14] + ((size_t)gi * 64 + pp) * 16; const float* bip = p.in[15] + ((size_t)gi * 64 + pp) * 16;
#pragma unroll
        for (int c = 0; c < 16; ++c) { const float br_ = brp[c], bi_ = bip[c]; bbr[c] = cr * br_ - ci * bi_; bbi[c] = cr * bi_ + ci * br_; }
    }
    for (int idx = tid; idx < 64 * 128; idx += NTHR) { const int t = idx >> 7, cc = idx & 127; us[idx] = bf2f(P[(size_t)(trow0 + t) * PW + PC_S5 + half * 128 + cc]); }
    __syncthreads();
    if (MODE == 1) {
        float xr = 0.f, xi = 0.f;
        for (int t = 0; t < 64; ++t) {
            float bur = 0.f, bui = 0.f;
#pragma unroll
            for (int c4 = 0; c4 < 4; ++c4) { const f32x4 u = *(const f32x4*)(us + t * 128 + wid * 16 + 4 * c4);
                bur += bbr[4 * c4] * u.x + bbr[4 * c4 + 1] * u.y + bbr[4 * c4 + 2] * u.z + bbr[4 * c4 + 3] * u.w;
                bui += bbi[4 * c4] * u.x + bbi[4 * c4 + 1] * u.y + bbi[4 * c4 + 2] * u.z + bbi[4 * c4 + 3] * u.w; }
            const float nxr = ar * xr - ai * xi + bur, nxi = ar * xi + ai * xr + bui; xr = nxr; xi = nxi;
        }
        *st = (f32x2){xr, xi};
        __syncthreads();
    } else {
        const f32x2 s0 = *st; float xr = s0.x, xi = s0.y;
        bf16x8 cf[4];
        { const int c = lane & 15, kq = lane >> 4;
            const float* crp = p.in[16] + ((size_t)gi * 16 + c) * 64; const float* cip = p.in[17] + ((size_t)gi * 16 + c) * 64;
#pragma unroll
            for (int s = 0; s < 4; ++s)
#pragma unroll
                for (int j = 0; j < 8; ++j) { const int k = 32 * s + 8 * kq + j; cf[s][j] = (short)f2bf(k < 64 ? crp[k] : -cip[k - 64]); }
        }
        const float dd = p.in[18][gi * 16 + (lane & 15)];
        bf16_t* ygl = (bf16_t*)(p.ws + WS_YGL);
        for (int t16 = 0; t16 < 4; ++t16) {
            for (int tt = 0; tt < 16; ++tt) { const int t = t16 * 16 + tt;
                float bur = 0.f, bui = 0.f;
#pragma unroll
                for (int c4 = 0; c4 < 4; ++c4) { const f32x4 u = *(const f32x4*)(us + t * 128 + wid * 16 + 4 * c4);
                    bur += bbr[4 * c4] * u.x + bbr[4 * c4 + 1] * u.y + bbr[4 * c4 + 2] * u.z + bbr[4 * c4 + 3] * u.w;
                    bui += bbi[4 * c4] * u.x + bbi[4 * c4 + 1] * u.y + bbi[4 * c4 + 2] * u.z + bbi[4 * c4 + 3] * u.w; }
                const float nxr = ar * xr - ai * xi + bur, nxi = ar * xi + ai * xr + bui; xr = nxr; xi = nxi;
                Xw[tt * 136 + pp] = f2bf(xr); Xw[tt * 136 + 64 + pp] = f2bf(xi);
            }
            __syncthreads();
            f32x4 a4 = (f32x4){0.f, 0.f, 0.f, 0.f};
#pragma unroll
            for (int s = 0; s < 4; ++s) { const bf16x8 a = *(const bf16x8*)(Xw + (lane & 15) * 136 + 32 * s + 8 * (lane >> 4)); a4 = MFMA16(a, cf[s], a4); }
#pragma unroll
            for (int j = 0; j < 4; ++j) { const int t = t16 * 16 + 4 * (lane >> 4) + j, c = lane & 15;
                const float y = a4[j] + dd * us[t * 128 + wid * 16 + c];
                ygl[(size_t)(trow0 + t) * 256 + g * 16 + c] = f2bf(geluf_(y)); }
            __syncthreads();
        }
    }
}

template <int MODE>
DI void lru_item(const Params& p, int l, int item, char* lds) {
    const int tid = otid(), sub = tid >> 8, ch = tid & 255;
    const int b = item >> 6, n64 = item & 63, trow0 = b * SEQ + n64 * 64, s0 = n64 * 64;
    const bf16_t* P = (const bf16_t*)(p.ws + WS_R);
    float* xcs = (float*)lds;
    const int tl = sub * 32;
    {
        const float* cwp = p.in[22] + (size_t)l * 4 * 256 + ch;
        const float w0 = cwp[0], w1 = cwp[256], w2 = cwp[512], w3 = cwp[768], cb = p.in[23][l * 256 + ch];
        float x0, x1, x2;
        x0 = (s0 + tl - 3 >= 0) ? bf2f(P[(size_t)(trow0 + tl - 3) * PW + PC_LX + ch]) : 0.f;
        x1 = (s0 + tl - 2 >= 0) ? bf2f(P[(size_t)(trow0 + tl - 2) * PW + PC_LX + ch]) : 0.f;
        x2 = (s0 + tl - 1 >= 0) ? bf2f(P[(size_t)(trow0 + tl - 1) * PW + PC_LX + ch]) : 0.f;
        for (int t = tl; t < tl + 32; ++t) { const float x3 = bf2f(P[(size_t)(trow0 + t) * PW + PC_LX + ch]);
            xcs[t * 256 + ch] = w0 * x0 + w1 * x1 + w2 * x2 + w3 * x3 + cb; x0 = x1; x1 = x2; x2 = x3; }
    }
    __syncthreads();
    {
        const int nb = ch >> 6, d = ch & 63;
        float wa[64], wi[64];
        const float* wap = p.in[24] + ((size_t)(l * 4 + nb) * 64) * 64 + d; const float* wip = p.in[26] + ((size_t)(l * 4 + nb) * 64) * 64 + d;
#pragma unroll
        for (int c = 0; c < 64; ++c) { wa[c] = wap[c * 64]; wi[c] = wip[c * 64]; }
        const float ba = p.in[25][l * 256 + ch], bi = p.in[27][l * 256 + ch], sp = softplusf_(-p.in[28][l * 256 + ch]);
        f32x2* st = (f32x2*)(p.ws + WS_LRUST) + (size_t)(b * 128 + n64 * 2 + sub) * 256 + ch;
        float hst = 0.f, Acc = 1.f;
        if (MODE == 3) hst = (*st).x;
        for (int t = tl; t < tl + 32; ++t) {
            float pa = ba, pi = bi;
#pragma unroll
            for (int c4 = 0; c4 < 16; ++c4) { const f32x4 xv = *(const f32x4*)(xcs + t * 256 + nb * 64 + 4 * c4);
                pa += xv.x * wa[4 * c4] + xv.y * wa[4 * c4 + 1] + xv.z * wa[4 * c4 + 2] + xv.w * wa[4 * c4 + 3];
                pi += xv.x * wi[4 * c4] + xv.y * wi[4 * c4 + 1] + xv.z * wi[4 * c4 + 2] + xv.w * wi[4 * c4 + 3]; }
            const float rg = sigmoidf_(pa), ig = sigmoidf_(pi), la = -8.f * rg * sp, a = expf(la), mult = sqrtf(-expm1f(2.f * la));
            hst = a * hst + xcs[t * 256 + ch] * ig * mult;
            if (MODE == 1) Acc *= a;
            else { const float y = bf2f(P[(size_t)(trow0 + t) * PW + PC_LY + ch]);
                ((bf16_t*)(p.ws + WS_BR))[(size_t)(trow0 + t) * D + 512 + ch] = f2bf(hst * geluf_(y)); }
        }
        if (MODE == 1) *st = (f32x2){Acc, hst};
    }
    __syncthreads();
}

constexpr int N_GDN = 2048, N_RET = 2048, N_S5 = 1024, N_LRU = 512;
template <int MODE>
DI void phase_mix(const Params& p, int l, char* lds) {
    constexpr int TOTAL = N_GDN + N_RET + N_S5 + N_LRU;
    for (int it = blockIdx.x; it < TOTAL; it += gridDim.x) {
        int r = it;
#ifndef NO_GDN
        if (r < N_GDN) { gdn_item<MODE>(p, l, r, lds); continue; }
#endif
        r -= N_GDN;
#ifndef NO_RET
        if (r < N_RET) { ret_item<MODE>(p, l, r, lds); continue; }
#endif
        r -= N_RET;
#ifndef NO_S5
        if (r < N_S5) { s5_item<MODE>(p, l, r, lds); continue; }
#endif
        r -= N_S5;
#ifndef NO_LRU
        lru_item<MODE>(p, l, r, lds);
#endif
    }
}
DI void phase_scan(const Params& p, int l, char* lds) {
    const int tid = otid(), lane = tid & 63, wid = tid >> 6;
    for (int it = blockIdx.x; it < 128 + 32 + 16 + 8; it += gridDim.x) {
        if (it < 128) {
            const int bh = it >> 2, q = it & 3, d = tid >> 3, ep = tid & 7, e0 = 16 * q + 2 * ep;
            float* Ml = (float*)lds; float* Sl = Ml + 64 * 68;
            float* base = (float*)(p.ws + WS_GMN) + (size_t)bh * 64 * 8192;
            f32x4 m0 = *(const f32x4*)(base + tid * 4), m1 = *(const f32x4*)(base + 2048 + tid * 4);
            f32x2 nn = *(const f32x2*)(base + 4096 + d * 64 + e0);
            float s0v = 0.f, s1v = 0.f;
            for (int n = 0; n < 64; ++n) {
                float* cur = base + (size_t)n * 8192;
                { const int i0 = tid * 4, i1 = 2048 + tid * 4;
                    *(f32x4*)(Ml + (i0 >> 6) * 68 + (i0 & 63)) = m0; *(f32x4*)(Ml + (i1 >> 6) * 68 + (i1 & 63)) = m1; }
                *(f32x2*)(Sl + d * 16 + 2 * ep) = (f32x2){s0v, s1v};
                *(f32x2*)(cur + 4096 + d * 64 + e0) = (f32x2){s0v, s1v};
                __syncthreads();
                float a0 = nn.x, a1 = nn.y;
                if (n + 1 < 64) { const float* nx = cur + 8192; m0 = *(const f32x4*)(nx + tid * 4); m1 = *(const f32x4*)(nx + 2048 + tid * 4); nn = *(const f32x2*)(nx + 4096 + d * 64 + e0); }
#pragma unroll 4
                for (int j4 = 0; j4 < 16; ++j4) { const f32x4 m = *(const f32x4*)(Ml + d * 68 + 4 * j4);
                    const f32x2 sa = *(const f32x2*)(Sl + (4 * j4) * 16 + 2 * ep), sb = *(const f32x2*)(Sl + (4 * j4 + 1) * 16 + 2 * ep);
                    const f32x2 sc = *(const f32x2*)(Sl + (4 * j4 + 2) * 16 + 2 * ep), sd = *(const f32x2*)(Sl + (4 * j4 + 3) * 16 + 2 * ep);
                    a0 += m.x * sa.x + m.y * sb.x + m.z * sc.x + m.w * sd.x; a1 += m.x * sa.y + m.y * sb.y + m.z * sc.y + m.w * sd.y; }
                s0v = a0; s1v = a1;
                __syncthreads();
            }
        } else if (it < 160) {
            const int bh = it - 128, h = bh & 3;
            const float gC = expf(64.f * log1pf(-exp2f(-5.f - (float)h)));
            float* base = (float*)(p.ws + WS_RKV) + (size_t)bh * 64 * 4096 + tid * 8;
            f32x4 sA = (f32x4){0.f, 0.f, 0.f, 0.f}, sB = sA;
            for (int n = 0; n < 64; ++n) { float* cur = base + (size_t)n * 4096;
                const f32x4 kA = *(const f32x4*)cur, kB = *(const f32x4*)(cur + 4);
                *(f32x4*)cur = sA; *(f32x4*)(cur + 4) = sB;
                sA = sA * gC + kA; sB = sB * gC + kB; }
        } else if (it < 176) {
            const int r = it - 160, b = r >> 1, half = r & 1, g = half * 8 + wid, gi = l * 16 + g;
            const float dt = expf(p.in[19][gi]), lr = p.in[12][gi * 64 + lane], li = p.in[13][gi * 64 + lane];
            const float mag = expf(64.f * lr * dt); float sn, cs; sincosf(64.f * li * dt, &sn, &cs);
            const float ar = mag * cs, ai = mag * sn;
            f32x2* st = (f32x2*)(p.ws + WS_S5ST) + (size_t)b * 64 * 1024 + g * 64 + lane;
            float cr = 0.f, ci = 0.f;
            for (int n = 0; n < 64; ++n) { const f32x2 e = st[(size_t)n * 1024]; st[(size_t)n * 1024] = (f32x2){cr, ci};
                const float nr = ar * cr - ai * ci + e.x, ni = ar * ci + ai * cr + e.y; cr = nr; ci = ni; }
        } else {
            const int b = it - 176;
            if (tid < 256) { f32x2* st = (f32x2*)(p.ws + WS_LRUST) + (size_t)b * 128 * 256 + tid; float c = 0.f;
                for (int n = 0; n < 128; ++n) { const f32x2 e = st[(size_t)n * 256]; st[(size_t)n * 256] = (f32x2){c, 0.f}; c = e.x * c + e.y; } }
        }
    }
}

__global__ void __launch_bounds__(NTHR) mega(Params p) {
    extern __shared__ __attribute__((aligned(16))) char lds[];
    cg::grid_group grid = cg::this_grid();
    for (int l = 0; l < DEPTH; ++l) {
        const float* xin = (l == 0) ? p.in[0] : p.out;
        const float* win_l = p.in[7] + (size_t)l * D * NIN;
        phase_wconv(p, l, lds);
        phase_norm<false>(p, xin, p.in[2] + l * D, win_l, lds);
        grid.sync();
        phase_ffn_a(p, (const bf16_t*)(p.ws + WS_WGU1), lds);
        grid.sync();
        phase_gemm_res(p, (const bf16_t*)(p.ws + WS_R), FF, (const bf16_t*)(p.ws + WS_WD1), xin, 0.5f, lds);
        grid.sync();
        phase_norm<true>(p, p.out, p.in[6] + l * D, win_l, lds);
        grid.sync();
        phase_proj(p, lds);
        grid.sync();
        phase_mix<1>(p, l, lds);
        grid.sync();
        phase_scan(p, l, lds);
        grid.sync();
        phase_mix<3>(p, l, lds);
        grid.sync();
        phase_glu(p, p.in[21] + l * 256, lds);
        grid.sync();
        phase_merge(p, lds);
        grid.sync();
        phase_gemm_res(p, (const bf16_t*)(p.ws + WS_R), D, (const bf16_t*)(p.ws + WS_WOUT), p.out, 1.0f, lds);
        grid.sync();
        phase_norm<false>(p, p.out, p.in[32] + l * D, win_l, lds);
        grid.sync();
        phase_ffn_a(p, (const bf16_t*)(p.ws + WS_WGU2), lds);
        grid.sync();
        phase_gemm_res(p, (const bf16_t*)(p.ws + WS_R), FF, (const bf16_t*)(p.ws + WS_WD2), p.out, 0.5f, lds);
        grid.sync();
    }
    phase_final_norm(p, p.in[36]);
}

extern "C" void kernel_launch(void* const* d_in, const int* in_sizes, int n_in, void* d_out, int out_size, void* d_ws, size_t ws_size, hipStream_t stream) {
    static int grid_blocks = 0;
    if (grid_blocks == 0) {
        if (n_in != 37 || ws_size < WS_END) { fprintf(stderr, "kernel_launch: unexpected n_in %d or ws_size %zu (< %zu)\n", n_in, ws_size, (size_t)WS_END); grid_blocks = -1; return; }
        int dev = 0, cus = 0, per_cu = 0;
        hipGetDevice(&dev);
        hipDeviceGetAttribute(&cus, hipDeviceAttributeMultiprocessorCount, dev);
        hipFuncSetAttribute((const void*)mega, hipFuncAttributeMaxDynamicSharedMemorySize, LDS_BYTES);
        hipOccupancyMaxActiveBlocksPerMultiprocessor(&per_cu, (const void*)mega, NTHR, LDS_BYTES);
        if (per_cu < 1) per_cu = 1;
        grid_blocks = cus * per_cu;
        fprintf(stderr, "kernel_launch: cus %d per_cu %d grid %d ws %zu need %zu\n", cus, per_cu, grid_blocks, ws_size, (size_t)WS_END);
    }
    if (grid_blocks < 0) return;
    Params p{};
    for (int i = 0; i < 37; ++i) p.in[i] = (const float*)d_in[i];
    p.out = (float*)d_out; p.ws = (char*)d_ws;
    void* args[] = {&p};
    hipError_t e = hipLaunchCooperativeKernel((const void*)mega, dim3(grid_blocks), dim3(NTHR), args, LDS_BYTES, stream);
    if (e != hipSuccess) fprintf(stderr, "cooperative launch failed: %s (grid %d)\n", hipGetErrorString(e), grid_blocks);
}
```

```cpp
#include <hip/hip_runtime.h>
#include <hip/hip_cooperative_groups.h>
#include <cstdio>
namespace cg = cooperative_groups;

typedef unsigned short bf16_t;
typedef short bf16x8 __attribute__((ext_vector_type(8)));
typedef float f32x16 __attribute__((ext_vector_type(16)));
typedef float f32x4 __attribute__((ext_vector_type(4)));
typedef float f32x2 __attribute__((ext_vector_type(2)));
typedef unsigned u32x4 __attribute__((ext_vector_type(4)));
typedef unsigned u32x2 __attribute__((ext_vector_type(2)));
#define DI __device__ __forceinline__

constexpr int T = 32768, D = 1024, FF = 2816, SEQ = 4096, NB = 8, DEPTH = 4;
constexpr int NIN = 6920, PW = 2816;
constexpr int NTHR = 512;
constexpr int LDS_BYTES = 147456;
constexpr int XCD_BAR_WORDS_ = 3456;
constexpr int LDS_BAR_OFF = LDS_BYTES - 16;
constexpr float EPS = 1e-6f;
constexpr int PC_QKV = 0, PC_Z = 768, PC_S5 = 1024, PC_LX = 1280, PC_LY = 1536, PC_RQ = 1792, PC_RK = 2048, PC_RV = 2304, PC_RG = 2560;

constexpr size_t al256(size_t x) { return (x + 255) & ~(size_t)255; }
constexpr size_t WS_WGU1 = 0;
constexpr size_t WS_WD1 = WS_WGU1 + (size_t)2 * FF * D * 2;
constexpr size_t WS_WGU2 = WS_WD1 + (size_t)D * FF * 2;
constexpr size_t WS_WD2 = WS_WGU2 + (size_t)2 * FF * D * 2;
constexpr size_t WS_WIN = WS_WD2 + (size_t)D * FF * 2;
constexpr size_t WS_WGATE = WS_WIN + (size_t)PW * D * 2;
constexpr size_t WS_WBR = WS_WGATE + (size_t)4096 * D * 2;
constexpr size_t WS_WOUT = WS_WBR + (size_t)4 * D * 256 * 2;
constexpr size_t WS_WGLU = WS_WOUT + (size_t)D * D * 2;
constexpr size_t WS_XN = WS_WGLU + (size_t)256 * 256 * 2;
constexpr size_t WS_R = WS_XN + (size_t)T * D * 2;
constexpr size_t WS_BR = WS_R + (size_t)T * PW * 2;
constexpr size_t WS_EXT = WS_BR + (size_t)T * D * 2;
constexpr size_t WS_GMN = WS_EXT + (size_t)T * 8 * 4;
constexpr size_t WS_RKV = WS_GMN + (size_t)2048 * 8192 * 4;
constexpr size_t WS_S5ST = WS_RKV + (size_t)2048 * 4096 * 4;
constexpr size_t WS_LRUST = WS_S5ST + (size_t)NB * 64 * 1024 * 8;
constexpr size_t WS_YGL = WS_LRUST + (size_t)NB * 128 * 256 * 8;
constexpr size_t WS_BAR = WS_YGL + (size_t)T * 256 * 2;
constexpr size_t WS_WLRU = WS_BAR + (size_t)XCD_BAR_WORDS_ * 4;
constexpr size_t WS_END = WS_WLRU + (size_t)8 * 64 * 64 * 2;

struct Params { const float* in[37]; float* out; char* ws; };
struct Ctx { const float* in[37]; float* out; char* ws; int wbase; };

typedef __bf16 bf16v2 __attribute__((ext_vector_type(2)));
DI bf16_t f2bf(float f) { return __builtin_bit_cast(unsigned short, (__bf16)f); }
DI float bf2f(bf16_t b) { return __uint_as_float(((unsigned)b) << 16); }
DI unsigned pack2(float lo, float hi) { f32x2 v = {lo, hi}; return __builtin_bit_cast(unsigned, __builtin_convertvector(v, bf16v2)); }
DI float sigmoidf_(float x) { return __builtin_amdgcn_rcpf(1.f + __expf(-x)); }
DI float siluf_(float x) { return x * sigmoidf_(x); }
DI float log1p_small(float y) { return y < 0.01f ? y * (1.f - y * (0.5f - y * (0.33333333f - 0.25f * y))) : __logf(1.f + y); }
DI float softplusf_(float x) { return fmaxf(x, 0.f) + log1p_small(__expf(-fabsf(x))); }
DI float neg_expm1(float z) { return fabsf(z) < 0.5f ? -z * (1.f + z * (0.5f + z * (0.16666667f + z * (0.041666668f + z * (0.0083333338f + z * (0.0013888889f + z * 0.0001984127f)))))) : 1.f - __expf(z); }
DI float geluf_(float x) { const float u = 0.7978845608028654f * (x + 0.044715f * x * x * x); return x * (1.f - __builtin_amdgcn_rcpf(1.f + __expf(2.f * u))); }
DI float shfl_xor_(float v, int o, int lane) { return __int_as_float(__builtin_amdgcn_ds_bpermute((lane ^ o) << 2, __float_as_int(v))); }
DI float shfl_up_(float v, int o, int lane) { return __int_as_float(__builtin_amdgcn_ds_bpermute((lane - o) << 2, __float_as_int(v))); }
DI float wave_sum(float v, int lane) {
#pragma unroll
    for (int o = 1; o < 64; o <<= 1) v += shfl_xor_(v, o, lane);
    return v;
}
DI int otid(int wbase) { int l; asm volatile("v_mbcnt_lo_u32_b32 %0, -1, 0\n\tv_mbcnt_hi_u32_b32 %0, -1, %0" : "=v"(l)); return wbase + l; }
DI int crow(int i, int h) { return (i & 3) + 8 * (i >> 2) + 4 * h; }
#define MFMA32(a, b, c) __builtin_amdgcn_mfma_f32_32x32x16_bf16((a), (b), (c), 0, 0, 0)
#define MFMA16(a, b, c) __builtin_amdgcn_mfma_f32_16x16x32_bf16((a), (b), (c), 0, 0, 0)

DI f32x16 mma32(const bf16_t* A, const bf16_t* B, int K, f32x16 acc, int lane) {
    const int r = lane & 31, hh = lane >> 5;
    for (int k0 = 0; k0 < K; k0 += 16) {
        bf16x8 a = *(const bf16x8*)(A + r * 72 + k0 + 8 * hh);
        bf16x8 b = *(const bf16x8*)(B + r * 72 + k0 + 8 * hh);
        acc = MFMA32(a, b, acc);
    }
    return acc;
}
DI f32x16 zero16() { f32x16 z;
#pragma unroll
    for (int i = 0; i < 16; ++i) z[i] = 0.f;
    return z; }

namespace pg8 {
#define PG8_LAS __attribute__((address_space(3)))
constexpr int BM = 256, BK = 64, HALF = 128, HTB = HALF * BK * 2  , STAGE_BYTES = 8 * HTB, NXCD = 8, WGM = 8;

__host__ __device__ __forceinline__ int lds_byte(int r, int c) { const int st = (r >> 4) * 2 + (c >> 5), rr = r & 15, cc = c & 31, ob = rr * 64 + cc * 2; return st * 1024 + (ob ^ (((ob >> 9) & 1) << 5)); }
__host__ __device__ __forceinline__ void stage_rc(int b, int& R, int& C) { const int st = b / 1024, sb = b % 1024, swz = sb ^ (((sb >> 9) & 1) << 5); R = (st >> 1) * 16 + swz / 64; C = (st & 1) * 32 + (swz % 64) / 2; }
__host__ __device__ __forceinline__ int perm32(int rho) { const int n = rho >> 4, i = rho & 15; return 8 * (i >> 2) + 4 * n + (i & 3); }
struct Unit { int pm, pn; };
struct Gemm { const bf16_t* A; const bf16_t* Bt; int M, N, K, lda, ldb, wbase; };
struct StaticOrder {
    int nM, nN, nwg, G, c;
    __host__ __device__ void init(int M, int N, int G_, int c_) { nM = M / BM; nN = N / BM; nwg = nM * nN; G = G_; c = c_; }
    __host__ __device__ bool next(int i, Unit& u) const {
        const long L = (long)i * G + c; if (L >= nwg) return false;
        int wgid = (int)L; { const int q = nwg / NXCD, r = nwg % NXCD, xcd = wgid % NXCD, off = wgid / NXCD; wgid = (xcd < r ? xcd * (q + 1) : r * (q + 1) + (xcd - r) * q) + off; }
        const int nig = WGM * nN, gid = wgid / nig, fm = gid * WGM, gsz = (nM - fm) < WGM ? (nM - fm) : WGM;
        u.pm = fm + ((wgid % nig) % gsz); u.pn = (wgid % nig) / gsz; return true;
    }
    __device__ __forceinline__ void a_ready(const Unit&) const {}
    __device__ __forceinline__ void done(const Unit&) const {}
};
struct UnitX { int pm, pn, n, kind; };
template <class Epi, class Sched, bool STAMP = false>
__device__ __forceinline__ void gemm_phase(PG8_LAS unsigned char* lds, const Gemm g, const Sched& S, const Epi& E, unsigned long long* stamps) {
    const int tid = otid(g.wbase), wid = __builtin_amdgcn_readfirstlane(tid >> 6), lane = tid & 63, wr = wid >> 2, wc = wid & 3, fr = lane & 15, fq = lane >> 4;
    const int K = g.K, nt = K / BK;
    int ts_lo = 0, ts_hi = 0, nts = 0; const unsigned long long rt_entry = STAMP ? (unsigned long long)wall_clock64() : 0ull;
#define PG8_STAMP() do { if (STAMP && wid == 0 && nts < 64) { const unsigned long long _c = (unsigned long long)clock64(); \
        ts_lo = (lane == nts) ? (int)(unsigned)_c : ts_lo; ts_hi = (lane == nts) ? (int)(unsigned)(_c >> 32) : ts_hi; ++nts; } } while (0)
    PG8_STAMP();
    unsigned voffA[2], voffB[2];
#pragma unroll
    for (int i = 0; i < 2; ++i) { int R, C; stage_rc(tid * 16 + i * 8192, R, C); const int Rb = Epi::PERM ? ((R & ~31) + perm32(R & 31)) : R;
        voffA[i] = (unsigned)(R * g.lda + C) * 2u; voffB[i] = (unsigned)(Rb * g.ldb + C) * 2u; }
    const size_t kstep = (size_t)(BK * 2);
    const size_t hstepA = (size_t)HALF * g.lda * 2, hstepB = (size_t)HALF * g.ldb * 2;
    const size_t tstepA = 2 * hstepA, tstepB = 2 * hstepB;
    const unsigned ldsw = (unsigned)wid * 1024u;
    const int aoff = lds_byte(wr * 64 + fr, fq * 8), boff = lds_byte(wc * 32 + fr, fq * 8);
#define PG8_SA(b, h) (((b) * 2 + (h)) * HTB)
#define PG8_SB(b, h) ((4 + (b) * 2 + (h)) * HTB)
#define PG8_STAGE(bufoff, gbase, voff) do { _Pragma("unroll") for (int _i = 0; _i < 2; ++_i) \
        __builtin_amdgcn_global_load_lds((const unsigned*)((const char*)(gbase) + (voff)[_i]), (PG8_LAS unsigned*)(lds + (bufoff) + ldsw + _i * 8192), 16, 0, 0); } while (0)
#define PG8_LDA(dst, b, h) do { _Pragma("unroll") for (int m = 0; m < 4; ++m) _Pragma("unroll") for (int k = 0; k < 2; ++k) dst[m][k] = *(const PG8_LAS bf16x8*)(lds + PG8_SA(b, h) + aoff + m * 2048 + k * 1024); } while (0)
#define PG8_LDB(dst, b, h) do { _Pragma("unroll") for (int n = 0; n < 2; ++n) _Pragma("unroll") for (int k = 0; k < 2; ++k) dst[n][k] = *(const PG8_LAS bf16x8*)(lds + PG8_SB(b, h) + boff + n * 2048 + k * 1024); } while (0)
#define PG8_MMA(ai, bj, At, Bt) do { __builtin_amdgcn_s_setprio(1); _Pragma("unroll") for (int m = 0; m < 4; ++m) _Pragma("unroll") for (int n = 0; n < 2; ++n) _Pragma("unroll") for (int k = 0; k < 2; ++k) \
        acc[ai][bj][m][n] = __builtin_amdgcn_mfma_f32_16x16x32_bf16(Bt[n][k], At[m][k], acc[ai][bj][m][n], 0, 0, 0); __builtin_amdgcn_s_setprio(0); } while (0)
#define PG8_WAIT_V(n) asm volatile("s_waitcnt vmcnt(" #n ")" ::: "memory")
#define PG8_WAIT_L(n) asm volatile("s_waitcnt lgkmcnt(" #n ")" ::: "memory")
#define PG8_BAR __builtin_amdgcn_s_barrier()
#define PG8_SCHED __builtin_amdgcn_sched_barrier(0)
    Unit cur, nxt; int ui = 0;
    if (!S.next(0, cur)) return;
    f32x4 acc[2][2][4][2];
    if constexpr (Epi::INIT) E.init(acc, cur, wr, wc, fr, fq); else {
#pragma unroll
    for (int a = 0; a < 2; ++a)
#pragma unroll
        for (int b = 0; b < 2; ++b)
#pragma unroll
            for (int m = 0; m < 4; ++m)
#pragma unroll
                for (int n = 0; n < 2; ++n) acc[a][b][m][n] = (f32x4){0.f, 0.f, 0.f, 0.f};
    }
    bf16x8 At[4][2], B0[2][2], B1[2][2];
    const char* cA = (const char*)g.A + (size_t)cur.pm * tstepA; const char* cB = (const char*)g.Bt + (size_t)cur.pn * tstepB;
    S.a_ready(cur);
    PG8_STAGE(PG8_SB(0, 0), cB, voffB); PG8_STAGE(PG8_SA(0, 0), cA, voffA); PG8_STAGE(PG8_SB(0, 1), cB + hstepB, voffB); PG8_STAGE(PG8_SA(0, 1), cA + hstepA, voffA);
    if (wr == 1) PG8_BAR;
    PG8_WAIT_V(4); PG8_BAR;
    PG8_STAGE(PG8_SB(1, 0), cB + kstep, voffB); PG8_STAGE(PG8_SA(1, 0), cA + kstep, voffA); PG8_STAGE(PG8_SB(1, 1), cB + hstepB + kstep, voffB);
    PG8_WAIT_V(6); PG8_BAR;
    PG8_STAMP();
    for (;;) {
        const bool has_next = S.next(ui + 1, nxt);
        const char* nA = has_next ? (const char*)g.A + (size_t)nxt.pm * tstepA : cA; const char* nB = has_next ? (const char*)g.Bt + (size_t)nxt.pn * tstepB : cB;
        for (int t = 0; t < nt; t += 2) {
            const bool last = (t == nt - 2);
            const char* a1 = cA + (size_t)(t + 1) * kstep;
            const char* a2 = last ? nA : cA + (size_t)(t + 2) * kstep; const char* b2 = last ? nB : cB + (size_t)(t + 2) * kstep;
            const char* a3 = a2 + kstep; const char* b3 = b2 + kstep;
            if (last && has_next) S.a_ready(nxt);
            PG8_LDB(B0, 0, 0); PG8_SCHED; PG8_LDA(At, 0, 0); PG8_STAGE(PG8_SA(1, 1), a1 + hstepA, voffA);
            PG8_WAIT_L(8); PG8_BAR; PG8_WAIT_L(0); PG8_MMA(0, 0, At, B0); PG8_BAR; PG8_SCHED;
            PG8_LDB(B1, 0, 1); PG8_STAGE(PG8_SB(0, 0), b2, voffB);
            PG8_BAR; PG8_WAIT_L(0); PG8_MMA(0, 1, At, B1); PG8_BAR;
            PG8_LDA(At, 0, 1); PG8_STAGE(PG8_SA(0, 0), a2, voffA);
            PG8_BAR; PG8_WAIT_L(0); PG8_MMA(1, 0, At, B0); PG8_BAR; PG8_SCHED;
            PG8_STAGE(PG8_SB(0, 1), b2 + hstepB, voffB);
            PG8_WAIT_V(6); PG8_BAR; PG8_MMA(1, 1, At, B1); PG8_BAR;
            PG8_LDB(B0, 1, 0); PG8_SCHED; PG8_LDA(At, 1, 0); PG8_STAGE(PG8_SA(0, 1), a2 + hstepA, voffA);
            PG8_WAIT_L(8); PG8_BAR; PG8_WAIT_L(0); PG8_MMA(0, 0, At, B0); PG8_BAR; PG8_SCHED;
            PG8_LDB(B1, 1, 1); PG8_STAGE(PG8_SB(1, 0), b3, voffB);
            PG8_BAR; PG8_WAIT_L(0); PG8_MMA(0, 1, At, B1); PG8_BAR;
            PG8_LDA(At, 1, 1); PG8_STAGE(PG8_SA(1, 0), a3, voffA);
            PG8_BAR; PG8_WAIT_L(0); PG8_MMA(1, 0, At, B0); PG8_BAR; PG8_SCHED;
            PG8_STAGE(PG8_SB(1, 1), b3 + hstepB, voffB);
            PG8_WAIT_V(6); PG8_BAR; PG8_MMA(1, 1, At, B1); PG8_BAR;
        }
        PG8_STAMP();
        if constexpr (Epi::INIT) { int fr_e = fr, fq_e = fq; asm volatile("" : "+v"(fr_e), "+v"(fq_e)); E.store_init(acc, cur, nxt, has_next, wr, wc, fr_e, fq_e); S.done(cur); }
        else if constexpr (!Epi::AFTER_DRAIN) { int fr_e = fr, fq_e = fq; asm volatile("" : "+v"(fr_e), "+v"(fq_e)); E(acc, cur, wr, wc, fr_e, fq_e); S.done(cur); }
        PG8_STAMP();
        if (!has_next) break;
        if constexpr (!Epi::INIT) {
#pragma unroll
        for (int a = 0; a < 2; ++a)
#pragma unroll
            for (int b = 0; b < 2; ++b)
#pragma unroll
                for (int m = 0; m < 4; ++m)
#pragma unroll
                    for (int n = 0; n < 2; ++n) acc[a][b][m][n] = (f32x4){0.f, 0.f, 0.f, 0.f};
        }
        cur = nxt; cA = nA; cB = nB; ++ui;
    }
    PG8_WAIT_V(0);
    if (wr == 0) PG8_BAR;
    PG8_BAR;
    if constexpr (Epi::AFTER_DRAIN) { E.fused(acc, cur, wr, wc, fr, fq, lds, wid, lane); S.done(cur); }
    PG8_STAMP();
    if (STAMP && wid == 0) { stamps[lane] = lane < nts ? (((unsigned long long)(unsigned)ts_hi << 32) | (unsigned)ts_lo) : 0ull;
        if (lane == 62) stamps[62] = rt_entry; if (lane == 63) stamps[63] = (unsigned long long)wall_clock64(); }
}
template <class Epi, class Sched>
__device__ __forceinline__ void gemm_phase_x(PG8_LAS unsigned char* lds, const Sched& S, const Epi& E) {
    constexpr bool STAMP = false; unsigned long long* stamps = nullptr;
    const int tid = otid(S.wbase), wid = __builtin_amdgcn_readfirstlane(tid >> 6), lane = tid & 63, wr = wid >> 2, wc = wid & 3, fr = lane & 15, fq = lane >> 4;
    int ts_lo = 0, ts_hi = 0, nts = 0; const unsigned long long rt_entry = STAMP ? (unsigned long long)wall_clock64() : 0ull;
#define PG8_STAMP() do { if (STAMP && wid == 0 && nts < 64) { const unsigned long long _c = (unsigned long long)clock64(); \
        ts_lo = (lane == nts) ? (int)(unsigned)_c : ts_lo; ts_hi = (lane == nts) ? (int)(unsigned)(_c >> 32) : ts_hi; ++nts; } } while (0)
    PG8_STAMP();
    unsigned voffA[2], voffB0[2], voffB1[2];
#pragma unroll
    for (int i = 0; i < 2; ++i) { int R, C; stage_rc(tid * 16 + i * 8192, R, C); const int Rb = Epi::PERM ? ((R & ~31) + perm32(R & 31)) : R;
        voffA[i] = (unsigned)(R * S.lda + C) * 2u; voffB0[i] = (unsigned)(Rb * S.ldb0 + C) * 2u; voffB1[i] = (unsigned)(Rb * S.ldb1 + C) * 2u; }
    const size_t kstep = (size_t)(BK * 2);
    const unsigned hstepA = (unsigned)HALF * S.lda * 2, hstepB0 = (unsigned)HALF * S.ldb0 * 2, hstepB1 = (unsigned)HALF * S.ldb1 * 2;
    const unsigned ldsw = (unsigned)wid * 1024u;
    const int aoff = lds_byte(wr * 64 + fr, fq * 8), boff = lds_byte(wc * 32 + fr, fq * 8);
#define PG8_SA(b, h) (((b) * 2 + (h)) * HTB)
#define PG8_SB(b, h) ((4 + (b) * 2 + (h)) * HTB)
#define PG8_STAGE(bufoff, gbase, voff) do { _Pragma("unroll") for (int _i = 0; _i < 2; ++_i) \
        __builtin_amdgcn_global_load_lds((const unsigned*)((const char*)(gbase) + (voff)[_i]), (PG8_LAS unsigned*)(lds + (bufoff) + ldsw + _i * 8192), 16, 0, 0); } while (0)
#define PG8_LDA(dst, b, h) do { _Pragma("unroll") for (int m = 0; m < 4; ++m) _Pragma("unroll") for (int k = 0; k < 2; ++k) dst[m][k] = *(const PG8_LAS bf16x8*)(lds + PG8_SA(b, h) + aoff + m * 2048 + k * 1024); } while (0)
#define PG8_LDB(dst, b, h) do { _Pragma("unroll") for (int n = 0; n < 2; ++n) _Pragma("unroll") for (int k = 0; k < 2; ++k) dst[n][k] = *(const PG8_LAS bf16x8*)(lds + PG8_SB(b, h) + boff + n * 2048 + k * 1024); } while (0)
#define PG8_MMA(ai, bj, At, Bt) do { __builtin_amdgcn_s_setprio(1); _Pragma("unroll") for (int m = 0; m < 4; ++m) _Pragma("unroll") for (int n = 0; n < 2; ++n) _Pragma("unroll") for (int k = 0; k < 2; ++k) \
        acc[ai][bj][m][n] = __builtin_amdgcn_mfma_f32_16x16x32_bf16(Bt[n][k], At[m][k], acc[ai][bj][m][n], 0, 0, 0); __builtin_amdgcn_s_setprio(0); } while (0)
#define PG8_WAIT_V(n) asm volatile("s_waitcnt vmcnt(" #n ")" ::: "memory")
#define PG8_WAIT_L(n) asm volatile("s_waitcnt lgkmcnt(" #n ")" ::: "memory")
#define PG8_BAR __builtin_amdgcn_s_barrier()
#define PG8_SCHED __builtin_amdgcn_sched_barrier(0)
    UnitX cur, nxt; int ui = 0;
    if (!S.next(0, cur)) return;
    f32x4 acc[2][2][4][2];
#pragma unroll
    for (int a = 0; a < 2; ++a)
#pragma unroll
        for (int b = 0; b < 2; ++b)
#pragma unroll
            for (int m = 0; m < 4; ++m)
#pragma unroll
                for (int n = 0; n < 2; ++n) acc[a][b][m][n] = (f32x4){0.f, 0.f, 0.f, 0.f};
    bf16x8 At[4][2], B0[2][2], B1[2][2];
    const char* cA = S.baseA(cur); const char* cB = S.baseB(cur);
    unsigned voffB[2] = {cur.kind ? voffB1[0] : voffB0[0], cur.kind ? voffB1[1] : voffB0[1]}; unsigned hstepB = cur.kind ? hstepB1 : hstepB0; int nt = S.nt(cur.kind);
    S.a_ready(cur);
    PG8_STAGE(PG8_SB(0, 0), cB, voffB); PG8_STAGE(PG8_SA(0, 0), cA, voffA); PG8_STAGE(PG8_SB(0, 1), cB + hstepB, voffB); PG8_STAGE(PG8_SA(0, 1), cA + hstepA, voffA);
    if (wr == 1) PG8_BAR;
    PG8_WAIT_V(4); PG8_BAR;
    PG8_STAGE(PG8_SB(1, 0), cB + kstep, voffB); PG8_STAGE(PG8_SA(1, 0), cA + kstep, voffA); PG8_STAGE(PG8_SB(1, 1), cB + hstepB + kstep, voffB);
    PG8_WAIT_V(6); PG8_BAR;
    PG8_STAMP();
    for (;;) {
        const bool has_next = S.next(ui + 1, nxt);
        const char* nA = has_next ? S.baseA(nxt) : cA; const char* nB = has_next ? S.baseB(nxt) : cB;
        const int nkind = has_next ? nxt.kind : cur.kind;
        const unsigned voffBn[2] = {nkind ? voffB1[0] : voffB0[0], nkind ? voffB1[1] : voffB0[1]}; const unsigned hstepBn = nkind ? hstepB1 : hstepB0;
        for (int t = 0; t < nt; t += 2) {
            const bool last = (t == nt - 2);
            const unsigned vB2[2] = {last ? voffBn[0] : voffB[0], last ? voffBn[1] : voffB[1]}; const unsigned hB2 = last ? hstepBn : hstepB;
            const char* a1 = cA + (size_t)(t + 1) * kstep;
            const char* a2 = last ? nA : cA + (size_t)(t + 2) * kstep; const char* b2 = last ? nB : cB + (size_t)(t + 2) * kstep;
            const char* a3 = a2 + kstep; const char* b3 = b2 + kstep;
            if (last && has_next) S.a_ready(nxt);
            PG8_LDB(B0, 0, 0); PG8_SCHED; PG8_LDA(At, 0, 0); PG8_STAGE(PG8_SA(1, 1), a1 + hstepA, voffA);
            PG8_WAIT_L(8); PG8_BAR; PG8_WAIT_L(0); PG8_MMA(0, 0, At, B0); PG8_BAR; PG8_SCHED;
            PG8_LDB(B1, 0, 1); PG8_STAGE(PG8_SB(0, 0), b2, vB2);
            PG8_BAR; PG8_WAIT_L(0); PG8_MMA(0, 1, At, B1); PG8_BAR;
            PG8_LDA(At, 0, 1); PG8_STAGE(PG8_SA(0, 0), a2, voffA);
            PG8_BAR; PG8_WAIT_L(0); PG8_MMA(1, 0, At, B0); PG8_BAR; PG8_SCHED;
            PG8_STAGE(PG8_SB(0, 1), b2 + hB2, vB2);
            PG8_WAIT_V(6); PG8_BAR; PG8_MMA(1, 1, At, B1); PG8_BAR;
            PG8_LDB(B0, 1, 0); PG8_SCHED; PG8_LDA(At, 1, 0); PG8_STAGE(PG8_SA(0, 1), a2 + hstepA, voffA);
            PG8_WAIT_L(8); PG8_BAR; PG8_WAIT_L(0); PG8_MMA(0, 0, At, B0); PG8_BAR; PG8_SCHED;
            PG8_LDB(B1, 1, 1); PG8_STAGE(PG8_SB(1, 0), b3, vB2);
            PG8_BAR; PG8_WAIT_L(0); PG8_MMA(0, 1, At, B1); PG8_BAR;
            PG8_LDA(At, 1, 1); PG8_STAGE(PG8_SA(1, 0), a3, voffA);
            PG8_BAR; PG8_WAIT_L(0); PG8_MMA(1, 0, At, B0); PG8_BAR; PG8_SCHED;
            PG8_STAGE(PG8_SB(1, 1), b3 + hB2, vB2);
            PG8_WAIT_V(6); PG8_BAR; PG8_MMA(1, 1, At, B1); PG8_BAR;
        }
        PG8_STAMP();
        if constexpr (!Epi::AFTER_DRAIN) { int fr_e = fr, fq_e = fq; asm volatile("" : "+v"(fr_e), "+v"(fq_e)); E(acc, cur, wr, wc, fr_e, fq_e); S.done(cur); }
        PG8_STAMP();
        if (!has_next) break;
#pragma unroll
        for (int a = 0; a < 2; ++a)
#pragma unroll
            for (int b = 0; b < 2; ++b)
#pragma unroll
                for (int m = 0; m < 4; ++m)
#pragma unroll
                    for (int n = 0; n < 2; ++n) acc[a][b][m][n] = (f32x4){0.f, 0.f, 0.f, 0.f};
        cur = nxt; cA = nA; cB = nB; ++ui; voffB[0] = voffBn[0]; voffB[1] = voffBn[1]; hstepB = hstepBn; nt = S.nt(cur.kind);
    }
    PG8_WAIT_V(0);
    if (wr == 0) PG8_BAR;
    PG8_BAR;
    if constexpr (Epi::AFTER_DRAIN) { E.fused(acc, cur, wr, wc, fr, fq, lds, wid, lane); S.done(cur); }
    PG8_STAMP();
    if (STAMP && wid == 0) { stamps[lane] = lane < nts ? (((unsigned long long)(unsigned)ts_hi << 32) | (unsigned)ts_lo) : 0ull;
        if (lane == 62) stamps[62] = rt_entry; if (lane == 63) stamps[63] = (unsigned long long)wall_clock64(); }
#undef PG8_STAMP
#undef PG8_SA
#undef PG8_SB
#undef PG8_STAGE
#undef PG8_LDA
#undef PG8_LDB
#undef PG8_MMA
#undef PG8_WAIT_V
#undef PG8_WAIT_L
#undef PG8_BAR
#undef PG8_SCHED
}
}

struct EpiFfnA {
    static constexpr bool PERM = true, AFTER_DRAIN = false, INIT = false;
    bf16_t* H;
    DI void operator()(const f32x4 (&acc)[2][2][4][2], const pg8::Unit& u, int wr, int wc, int fr, int fq) const {
        const int row0 = u.pm * 256 + wr * 64 + fr, col0 = u.pn * 128 + wc * 32 + 8 * fq;
#pragma unroll
        for (int ai = 0; ai < 2; ++ai)
#pragma unroll
            for (int m = 0; m < 4; ++m) { const f32x4 g0 = acc[ai][0][m][0], g1 = acc[ai][0][m][1], u0 = acc[ai][1][m][0], u1 = acc[ai][1][m][1];
                u32x4 w; w.x = pack2(siluf_(g0[0]) * u0[0], siluf_(g0[1]) * u0[1]); w.y = pack2(siluf_(g0[2]) * u0[2], siluf_(g0[3]) * u0[3]);
                w.z = pack2(siluf_(g1[0]) * u1[0], siluf_(g1[1]) * u1[1]); w.w = pack2(siluf_(g1[2]) * u1[2], siluf_(g1[3]) * u1[3]);
                *(u32x4*)(H + (size_t)(row0 + ai * 128 + m * 16) * FF + col0) = w; }
    }
};
struct EpiRes {
    static constexpr bool PERM = false, AFTER_DRAIN = false, INIT = true;
    float* out; const float* xin; int half;
    DI void init(f32x4 (&acc)[2][2][4][2], const pg8::Unit& u, int wr, int wc, int fr, int fq) const {
        const int row0 = u.pm * 256 + wr * 64 + fr, col0 = u.pn * 256 + wc * 32 + 4 * fq; const float rs = half ? 2.0f : 1.0f;
#pragma unroll
        for (int ai = 0; ai < 2; ++ai)
#pragma unroll
            for (int m = 0; m < 4; ++m) { const size_t o = (size_t)(row0 + ai * 128 + m * 16) * D + col0;
#pragma unroll
                for (int bj = 0; bj < 2; ++bj)
#pragma unroll
                    for (int n = 0; n < 2; ++n) acc[ai][bj][m][n] = *(const f32x4*)(xin + o + bj * 128 + n * 16) * rs; }
    }
    DI void store_init(f32x4 (&acc)[2][2][4][2], const pg8::Unit& u, const pg8::Unit& nx, bool has_next, int wr, int wc, int fr, int fq) const {
        const int row0 = u.pm * 256 + wr * 64 + fr, col0 = u.pn * 256 + wc * 32 + 4 * fq, row0n = nx.pm * 256 + wr * 64 + fr, col0n = nx.pn * 256 + wc * 32 + 4 * fq;
        const float scale = half ? 0.5f : 1.0f, rs = half ? 2.0f : 1.0f;
#pragma unroll
        for (int ai = 0; ai < 2; ++ai)
#pragma unroll
            for (int m = 0; m < 4; ++m) { const size_t o = (size_t)(row0 + ai * 128 + m * 16) * D + col0, on = (size_t)(row0n + ai * 128 + m * 16) * D + col0n;
#pragma unroll
                for (int bj = 0; bj < 2; ++bj)
#pragma unroll
                    for (int n = 0; n < 2; ++n) { *(f32x4*)(out + o + bj * 128 + n * 16) = acc[ai][bj][m][n] * scale;
                        if (has_next) acc[ai][bj][m][n] = *(const f32x4*)(xin + on + bj * 128 + n * 16) * rs; } }
    }
    DI void operator()(const f32x4 (&acc)[2][2][4][2], const pg8::Unit& u, int wr, int wc, int fr, int fq) const {
        const int row0 = u.pm * 256 + wr * 64 + fr, col0 = u.pn * 256 + wc * 32 + 4 * fq; const float scale = half ? 0.5f : 1.0f;
#pragma unroll
        for (int ai = 0; ai < 2; ++ai)
#pragma unroll
            for (int m = 0; m < 4; ++m) { const size_t o = (size_t)(row0 + ai * 128 + m * 16) * D + col0;
#pragma unroll
                for (int bj = 0; bj < 2; ++bj)
#pragma unroll
                    for (int n = 0; n < 2; ++n) *(f32x4*)(out + o + bj * 128 + n * 16) = acc[ai][bj][m][n] * scale; }
    }
};
struct EpiBf {
    static constexpr bool PERM = true, AFTER_DRAIN = false, INIT = false;
    bf16_t* O; int ldc;
    DI void operator()(const f32x4 (&acc)[2][2][4][2], const pg8::Unit& u, int wr, int wc, int fr, int fq) const {
        const int row0 = u.pm * 256 + wr * 64 + fr, col0 = u.pn * 256 + wc * 32 + 8 * fq;
#pragma unroll
        for (int ai = 0; ai < 2; ++ai)
#pragma unroll
            for (int m = 0; m < 4; ++m)
#pragma unroll
                for (int bj = 0; bj < 2; ++bj) { const f32x4 v0 = acc[ai][bj][m][0], v1 = acc[ai][bj][m][1];
                    u32x4 w; w.x = pack2(v0[0], v0[1]); w.y = pack2(v0[2], v0[3]); w.z = pack2(v1[0], v1[1]); w.w = pack2(v1[2], v1[3]);
                    *(u32x4*)(O + (size_t)(row0 + ai * 128 + m * 16) * ldc + col0 + bj * 128) = w; }
    }
};
struct EpiGlu {
    static constexpr bool PERM = true, AFTER_DRAIN = false, INIT = false;
    const bf16_t* Y; bf16_t* BRo; const float* bias;
    DI void operator()(const f32x4 (&acc)[2][2][4][2], const pg8::Unit& u, int wr, int wc, int fr, int fq) const {
        const int row0 = u.pm * 256 + wr * 64 + fr, col0 = wc * 32 + 8 * fq;
#pragma unroll
        for (int ai = 0; ai < 2; ++ai)
#pragma unroll
            for (int m = 0; m < 4; ++m)
#pragma unroll
                for (int bj = 0; bj < 2; ++bj) { const int row = row0 + ai * 128 + m * 16, j = col0 + bj * 128;
                    const u32x4 yv = *(const u32x4*)(Y + (size_t)row * 256 + j);
                    const f32x4 b0 = *(const f32x4*)(bias + j), b1 = *(const f32x4*)(bias + j + 4);
                    const f32x4 v0 = acc[ai][bj][m][0] + b0, v1 = acc[ai][bj][m][1] + b1;
                    u32x4 w;
                    w.x = pack2(__uint_as_float(yv.x << 16) * sigmoidf_(v0[0]), __uint_as_float(yv.x & 0xffff0000u) * sigmoidf_(v0[1]));
                    w.y = pack2(__uint_as_float(yv.y << 16) * sigmoidf_(v0[2]), __uint_as_float(yv.y & 0xffff0000u) * sigmoidf_(v0[3]));
                    w.z = pack2(__uint_as_float(yv.z << 16) * sigmoidf_(v1[0]), __uint_as_float(yv.z & 0xffff0000u) * sigmoidf_(v1[1]));
                    w.w = pack2(__uint_as_float(yv.w << 16) * sigmoidf_(v1[2]), __uint_as_float(yv.w & 0xffff0000u) * sigmoidf_(v1[3]));
                    *(u32x4*)(BRo + (size_t)row * D + 256 + j) = w; }
    }
};
template <class Epi>
DI void run_gemm8(char* lds, int wbase, const bf16_t* A, int lda, const bf16_t* Bt, int ldb, int M, int N, int K, const Epi& E) {
    pg8::Gemm g; g.wbase = wbase; g.A = A; g.Bt = Bt; g.M = M; g.N = N; g.K = K; g.lda = lda; g.ldb = ldb;
    pg8::StaticOrder S; S.init(M, N, (int)gridDim.x, (int)blockIdx.x);
    pg8::gemm_phase<Epi, pg8::StaticOrder, false>((PG8_LAS unsigned char*)lds, g, S, E, nullptr);
}

DI void wconv_tile(int wbase, const float* src0, const float* src1, int ld, int mode, int c0, int K, bf16_t* dst, int tile, float* tl) {
    const int nkt = K / 64, tr = tile / nkt, tk = tile % nkt, R0 = tr * 64, k0 = tk * 64, tid = otid(wbase);
    {
        const int rl = tid & 63, kq = tid >> 6, R = R0 + rl;
        const float* src = src0; int col;
        if (mode == 0) col = R + c0;
        else if (mode == 1) { if ((R & 255) >= 128) src = src1; col = (R >> 8) * 128 + (R & 127); }
        else col = R < 1024 ? R : R + 8;
#pragma unroll
        for (int i = 0; i < 8; ++i) { const int k = kq + 8 * i; tl[k * 65 + rl] = src[(size_t)(k0 + k) * ld + col]; }
    }
    __syncthreads();
    {
        const int kp = tid & 31, rr = tid >> 5;
#pragma unroll
        for (int i = 0; i < 4; ++i) { const int R = rr + 16 * i;
            *(unsigned*)(dst + (size_t)(R0 + R) * K + k0 + 2 * kp) = pack2(tl[(2 * kp) * 65 + R], tl[(2 * kp + 1) * 65 + R]); }
    }
    __syncthreads();
}
DI void phase_wconv(const Ctx& p, int l, char* lds) {
    float* tl = (float*)lds;
    const float* g1 = p.in[3] + (size_t)l * D * FF; const float* u1 = p.in[4] + (size_t)l * D * FF; const float* d1 = p.in[5] + (size_t)l * FF * D;
    const float* g2 = p.in[33] + (size_t)l * D * FF; const float* u2 = p.in[34] + (size_t)l * D * FF; const float* d2 = p.in[35] + (size_t)l * FF * D;
    const float* win = p.in[7] + (size_t)l * D * NIN; const float* wbr = p.in[30] + (size_t)l * 4 * 256 * D; const float* wout = p.in[31] + (size_t)l * D * D;
    const float* wglu = p.in[20] + (size_t)l * 65536;
    constexpr int I_GU = 88 * 16, I_D = 16 * 44, I_IN = 44 * 16, I_GATE = 64 * 16, I_BR = 16 * 4, I_OUT = 16 * 16, I_GLU = 16, I_LRU = 8;
    constexpr int TOTAL = 2 * I_GU + 2 * I_D + I_IN + I_GATE + 4 * I_BR + I_OUT + I_GLU + I_LRU;
    for (int it = blockIdx.x; it < TOTAL; it += gridDim.x) {
        int r = it;
        if (r < I_GU) { wconv_tile(p.wbase, g1, u1, FF, 1, 0, D, (bf16_t*)(p.ws + WS_WGU1), r, tl); continue; } r -= I_GU;
        if (r < I_GU) { wconv_tile(p.wbase, g2, u2, FF, 1, 0, D, (bf16_t*)(p.ws + WS_WGU2), r, tl); continue; } r -= I_GU;
        if (r < I_D) { wconv_tile(p.wbase, d1, d1, D, 0, 0, FF, (bf16_t*)(p.ws + WS_WD1), r, tl); continue; } r -= I_D;
        if (r < I_D) { wconv_tile(p.wbase, d2, d2, D, 0, 0, FF, (bf16_t*)(p.ws + WS_WD2), r, tl); continue; } r -= I_D;
        if (r < I_IN) { wconv_tile(p.wbase, win, win, NIN, 2, 0, D, (bf16_t*)(p.ws + WS_WIN), r, tl); continue; } r -= I_IN;
        if (r < I_GATE) { wconv_tile(p.wbase, win, win, NIN, 0, 2824, D, (bf16_t*)(p.ws + WS_WGATE), r, tl); continue; } r -= I_GATE;
        if (r < 4 * I_BR) { const int n = r / I_BR; wconv_tile(p.wbase, wbr + (size_t)n * 256 * D, wbr, D, 0, 0, 256, (bf16_t*)(p.ws + WS_WBR) + (size_t)n * D * 256, r % I_BR, tl); continue; } r -= 4 * I_BR;
        if (r < I_OUT) { wconv_tile(p.wbase, wout, wout, D, 0, 0, D, (bf16_t*)(p.ws + WS_WOUT), r, tl); continue; } r -= I_OUT;
        if (r < I_GLU) { wconv_tile(p.wbase, wglu, wglu, 256, 0, 0, 256, (bf16_t*)(p.ws + WS_WGLU), r, tl); continue; } r -= I_GLU;
        { const int gate = r >> 2, nb = r & 3; const float* wsrc = p.in[gate ? 26 : 24] + ((size_t)(l * 4 + nb) * 64) * 64;
            wconv_tile(p.wbase, wsrc, wsrc, 64, 0, 0, 64, (bf16_t*)(p.ws + WS_WLRU) + (size_t)r * 4096, 0, tl); }
    }
}

template <bool EXT>
DI void phase_norm(const Ctx& p, const float* x, const float* nw, const float* win_l, char* lds) {
    const int tid = otid(p.wbase), lane = tid & 63, wid = p.wbase >> 6;
    bf16_t* xn = (bf16_t*)(p.ws + WS_XN);
    float* ext = (float*)(p.ws + WS_EXT);
    float* wext = (float*)lds;
    if (EXT) {
        for (int idx = tid; idx < 8192; idx += NTHR) { const int k = idx >> 3, c = idx & 7; wext[c * 1024 + k] = nw[k] * win_l[(size_t)k * NIN + 1024 + c]; }
        __syncthreads();
    }
    f32x4 nv[4];
#pragma unroll
    for (int j = 0; j < 4; ++j) nv[j] = *(const f32x4*)(nw + 4 * lane + 256 * j);
    constexpr int RPI = EXT ? 1 : 4;
    const int rstride = gridDim.x * 8;
    for (int row0 = blockIdx.x * 8 + wid; row0 < T; row0 += rstride * RPI) {
        f32x4 v[RPI][4]; float s[RPI];
#pragma unroll
        for (int q = 0; q < RPI; ++q) { const int row = row0 + q * rstride; s[q] = 0.f;
            if (row < T) {
#pragma unroll
                for (int j = 0; j < 4; ++j) v[q][j] = *(const f32x4*)(x + (size_t)row * D + 4 * lane + 256 * j);
            } else {
#pragma unroll
                for (int j = 0; j < 4; ++j) v[q][j] = (f32x4){0.f, 0.f, 0.f, 0.f};
            } }
#pragma unroll
        for (int q = 0; q < RPI; ++q) {
#pragma unroll
            for (int j = 0; j < 4; ++j) s[q] += v[q][j].x * v[q][j].x + v[q][j].y * v[q][j].y + v[q][j].z * v[q][j].z + v[q][j].w * v[q][j].w; }
#pragma unroll
        for (int o = 1; o < 64; o <<= 1) {
#pragma unroll
            for (int q = 0; q < RPI; ++q) s[q] += shfl_xor_(s[q], o, lane); }
#pragma unroll
        for (int q = 0; q < RPI; ++q) { const int row = row0 + q * rstride; if (row < T) {
            const float inv = rsqrtf(s[q] * (1.f / D) + EPS);
#pragma unroll
            for (int j = 0; j < 4; ++j) {
                u32x2 o; o.x = pack2(v[q][j].x * inv * nv[j].x, v[q][j].y * inv * nv[j].y); o.y = pack2(v[q][j].z * inv * nv[j].z, v[q][j].w * inv * nv[j].w);
                *(u32x2*)(xn + (size_t)row * D + 4 * lane + 256 * j) = o;
            }
            if (EXT) {
                float e[8];
#pragma unroll
                for (int c = 0; c < 8; ++c) { float a = 0.f;
#pragma unroll
                    for (int j = 0; j < 4; ++j) { const f32x4 w = *(const f32x4*)(wext + c * 1024 + 4 * lane + 256 * j); a += v[q][j].x * w.x + v[q][j].y * w.y + v[q][j].z * w.z + v[q][j].w * w.w; }
                    e[c] = a; }
#pragma unroll
                for (int o = 1; o < 64; o <<= 1) {
#pragma unroll
                    for (int c = 0; c < 8; ++c) e[c] += shfl_xor_(e[c], o, lane); }
                if (lane == 0) { *(f32x4*)(ext + (size_t)row * 8) = (f32x4){e[0] * inv, e[1] * inv, e[2] * inv, e[3] * inv}; *(f32x4*)(ext + (size_t)row * 8 + 4) = (f32x4){e[4] * inv, e[5] * inv, e[6] * inv, e[7] * inv}; }
            }
        } }
    }
    if (EXT) __syncthreads();
}
DI void phase_final_norm(const Ctx& p, const float* nw) {
    const int tid = otid(p.wbase), lane = tid & 63, wid = p.wbase >> 6;
    f32x4 nv[4];
#pragma unroll
    for (int j = 0; j < 4; ++j) nv[j] = *(const f32x4*)(nw + 4 * lane + 256 * j);
    constexpr int RPI = 4; const int rstride = gridDim.x * 8;
    for (int row0 = blockIdx.x * 8 + wid; row0 < T; row0 += rstride * RPI) {
        f32x4 v[RPI][4]; float s[RPI];
#pragma unroll
        for (int q = 0; q < RPI; ++q) { const int row = row0 + q * rstride; s[q] = 0.f;
#pragma unroll
            for (int j = 0; j < 4; ++j) v[q][j] = (row < T) ? *(const f32x4*)(p.out + (size_t)row * D + 4 * lane + 256 * j) : (f32x4){0.f, 0.f, 0.f, 0.f}; }
#pragma unroll
        for (int q = 0; q < RPI; ++q) {
#pragma unroll
            for (int j = 0; j < 4; ++j) s[q] += v[q][j].x * v[q][j].x + v[q][j].y * v[q][j].y + v[q][j].z * v[q][j].z + v[q][j].w * v[q][j].w; }
#pragma unroll
        for (int o = 1; o < 64; o <<= 1) {
#pragma unroll
            for (int q = 0; q < RPI; ++q) s[q] += shfl_xor_(s[q], o, lane); }
#pragma unroll
        for (int q = 0; q < RPI; ++q) { const int row = row0 + q * rstride; if (row < T) {
            const float inv = rsqrtf(s[q] * (1.f / D) + EPS);
#pragma unroll
            for (int j = 0; j < 4; ++j) *(f32x4*)(p.out + (size_t)row * D + 4 * lane + 256 * j) = (f32x4){v[q][j].x * inv * nv[j].x, v[q][j].y * inv * nv[j].y, v[q][j].z * inv * nv[j].z, v[q][j].w * inv * nv[j].w}; } }
    }
}

DI void phase_ffn_a(const Ctx& p, const bf16_t* wgu, char* lds) {
    EpiFfnA E; E.H = (bf16_t*)(p.ws + WS_R);
    run_gemm8(lds, p.wbase, (const bf16_t*)(p.ws + WS_XN), D, wgu, D, T, 2 * FF, D, E);
}
DI void phase_gemm_res(const Ctx& p, const bf16_t* A, int K, const bf16_t* Wt, const float* xin, float scale, char* lds) {
    EpiRes E; E.out = p.out; E.xin = xin; E.half = (scale == 0.5f) ? 1 : 0;
    run_gemm8(lds, p.wbase, A, K, Wt, K, T, D, K, E);
}
DI void phase_proj(const Ctx& p, char* lds) {
    EpiBf E; E.O = (bf16_t*)(p.ws + WS_R); E.ldc = PW;
    run_gemm8(lds, p.wbase, (const bf16_t*)(p.ws + WS_XN), D, (const bf16_t*)(p.ws + WS_WIN), D, T, PW, D, E);
}
DI void phase_glu(const Ctx& p, const float* bglu, char* lds) {
    EpiGlu E; E.Y = (const bf16_t*)(p.ws + WS_YGL); E.BRo = (bf16_t*)(p.ws + WS_BR); E.bias = bglu;
    run_gemm8(lds, p.wbase, (const bf16_t*)(p.ws + WS_YGL), 256, (const bf16_t*)(p.ws + WS_WGLU), 256, T, 256, 256, E);
}
struct MergeSched {
    pg8::StaticOrder so; const char* xn; const char* br; const char* wg; const char* wb; int lda, ldb0, ldb1, wbase;
    DI bool next(int i, pg8::UnitX& u) const { pg8::Unit t; if (!so.next(i >> 3, t)) return false; u.pm = t.pm; u.pn = t.pn; u.n = (i >> 1) & 3; u.kind = i & 1; return true; }
    DI const char* baseA(const pg8::UnitX& u) const { return (u.kind ? br + u.n * 512 : xn) + (size_t)u.pm * (256 * 1024 * 2); }
    DI const char* baseB(const pg8::UnitX& u) const { return u.kind ? wb + ((size_t)u.n * 1024 + u.pn * 256) * (256 * 2) : wg + ((size_t)u.n * 1024 + u.pn * 256) * (1024 * 2); }
    DI int nt(int kind) const { return kind ? 4 : 16; }
    DI void a_ready(const pg8::UnitX&) const {}
    DI void done(const pg8::UnitX&) const {}
};
struct EpiMerge {
    static constexpr bool PERM = true, AFTER_DRAIN = false;
    char* SG; char* SM; bf16_t* MG;
    DI void operator()(const f32x4 (&acc)[2][2][4][2], const pg8::UnitX& u, int wr, int wc, int fr, int fq) const {
        unsigned voff = (unsigned)(wr * 256 + wc * 64 + fq * 16 + fr) * 16u; asm volatile("" : "+v"(voff));
        if (u.kind == 0) {
#pragma unroll
            for (int ai = 0; ai < 2; ++ai)
#pragma unroll
                for (int bj = 0; bj < 2; ++bj)
#pragma unroll
                    for (int m = 0; m < 4; ++m) { const int idx = (ai * 2 + bj) * 4 + m; const f32x4 v0 = acc[ai][bj][m][0], v1 = acc[ai][bj][m][1];
                        u32x4 w; w.x = pack2(sigmoidf_(v0[0]), sigmoidf_(v0[1])); w.y = pack2(sigmoidf_(v0[2]), sigmoidf_(v0[3])); w.z = pack2(sigmoidf_(v1[0]), sigmoidf_(v1[1])); w.w = pack2(sigmoidf_(v1[2]), sigmoidf_(v1[3]));
                        *(u32x4*)(SG + (size_t)(idx * 8192) + voff) = w; }
        } else {
            const int row0 = u.pm * 256 + wr * 64 + fr, col0 = u.pn * 256 + wc * 32 + 8 * fq;
#pragma unroll
            for (int ai = 0; ai < 2; ++ai)
#pragma unroll
                for (int bj = 0; bj < 2; ++bj) {
                    u32x4 g[4]; f32x4 s0[4], s1[4];
#pragma unroll
                    for (int m = 0; m < 4; ++m) { const int idx = (ai * 2 + bj) * 4 + m; g[m] = *(const u32x4*)(SG + (size_t)(idx * 8192) + voff);
                        if (u.n > 0) { s0[m] = *(const f32x4*)(SM + (size_t)(2 * idx * 8192) + voff); s1[m] = *(const f32x4*)(SM + (size_t)((2 * idx + 1) * 8192) + voff); }
                        else { s0[m] = (f32x4){0.f, 0.f, 0.f, 0.f}; s1[m] = s0[m]; } }
#pragma unroll
                    for (int m = 0; m < 4; ++m) { const int idx = (ai * 2 + bj) * 4 + m;
                        f32x4 v0 = acc[ai][bj][m][0], v1 = acc[ai][bj][m][1];
                        v0[0] = v0[0] * __uint_as_float(g[m].x << 16) + s0[m][0]; v0[1] = v0[1] * __uint_as_float(g[m].x & 0xffff0000u) + s0[m][1];
                        v0[2] = v0[2] * __uint_as_float(g[m].y << 16) + s0[m][2]; v0[3] = v0[3] * __uint_as_float(g[m].y & 0xffff0000u) + s0[m][3];
                        v1[0] = v1[0] * __uint_as_float(g[m].z << 16) + s1[m][0]; v1[1] = v1[1] * __uint_as_float(g[m].z & 0xffff0000u) + s1[m][1];
                        v1[2] = v1[2] * __uint_as_float(g[m].w << 16) + s1[m][2]; v1[3] = v1[3] * __uint_as_float(g[m].w & 0xffff0000u) + s1[m][3];
                        if (u.n < 3) { *(f32x4*)(SM + (size_t)(2 * idx * 8192) + voff) = v0; *(f32x4*)(SM + (size_t)((2 * idx + 1) * 8192) + voff) = v1; }
                        else { u32x4 w; w.x = pack2(v0[0], v0[1]); w.y = pack2(v0[2], v0[3]); w.z = pack2(v1[0], v1[1]); w.w = pack2(v1[2], v1[3]);
                            *(u32x4*)(MG + (size_t)(row0 + ai * 128 + m * 16) * D + col0 + bj * 128) = w; } }
                }
        }
    }
};
DI void phase_merge(const Ctx& p, char* lds) {
    MergeSched S; S.so.init(T, D, (int)gridDim.x, (int)blockIdx.x);
    S.xn = p.ws + WS_XN; S.br = p.ws + WS_BR; S.wg = p.ws + WS_WGATE; S.wb = p.ws + WS_WBR; S.lda = D; S.ldb0 = D; S.ldb1 = 256; S.wbase = p.wbase;
    EpiMerge E; char* sc = p.ws + WS_GMN + (size_t)blockIdx.x * 393216;
    E.SG = sc; E.SM = sc + 131072; E.MG = (bf16_t*)(p.ws + WS_R);
    pg8::gemm_phase_x<EpiMerge, MergeSched>((PG8_LAS unsigned char*)lds, S, E);
}

template <int MODE>
DI void gdn_item(const Ctx& p, int l, int item, char* lds) {
    const int tid = otid(p.wbase), lane = tid & 63, wid = p.wbase >> 6, r = lane & 31, hh = lane >> 5;
    const int bh = item >> 6, n = item & 63, b = bh >> 2, h = bh & 3;
    const int trow0 = b * SEQ + n * 64, s0 = n * 64;
    const bf16_t* P = (const bf16_t*)(p.ws + WS_R);
    const float* ext = (const float*)(p.ws + WS_EXT);
    float* gmn = (float*)(p.ws + WS_GMN) + (size_t)item * 8192;
    bf16_t* BRp = (bf16_t*)(p.ws + WS_BR);
    if (MODE == 3) {
        bf16_t* SbT = (bf16_t*)lds; bf16_t* qpb = SbT + 64 * 72; bf16_t* opb = qpb + 64 * 72; float* of = (float*)(lds + 3 * 9216);
        const int row = tid >> 3, w8 = tid & 7;
        const f32x4 sv0 = *(const f32x4*)(gmn + 4096 + tid * 4), sv1 = *(const f32x4*)(gmn + 4096 + 2048 + tid * 4);
        bf16_t* brow = BRp + (size_t)(trow0 + row) * D + h * 64 + w8 * 8;
        const u32x4 qv = *(const u32x4*)(brow + 256), ov = *(const u32x4*)brow;
        const u32x4 zraw = *(const u32x4*)(P + (size_t)(trow0 + row) * PW + PC_Z + h * 64 + w8 * 8);
        { const int idx = tid * 4, d = idx >> 6, e = idx & 63;
            SbT[e * 72 + d] = f2bf(sv0.x); SbT[(e + 1) * 72 + d] = f2bf(sv0.y); SbT[(e + 2) * 72 + d] = f2bf(sv0.z); SbT[(e + 3) * 72 + d] = f2bf(sv0.w); }
        { const int idx = (tid + NTHR) * 4, d = idx >> 6, e = idx & 63;
            SbT[e * 72 + d] = f2bf(sv1.x); SbT[(e + 1) * 72 + d] = f2bf(sv1.y); SbT[(e + 2) * 72 + d] = f2bf(sv1.z); SbT[(e + 3) * 72 + d] = f2bf(sv1.w); }
        *(u32x4*)(qpb + row * 72 + w8 * 8) = qv; *(u32x4*)(opb + row * 72 + w8 * 8) = ov;
        __syncthreads();
        if (wid < 4) { const int ti = wid >> 1, tj = wid & 1;
            f32x16 a = mma32(qpb + ti * 32 * 72, SbT + tj * 32 * 72, 64, zero16(), lane);
#pragma unroll
            for (int i = 0; i < 16; ++i) { const int t = ti * 32 + crow(i, hh), e = tj * 32 + r; of[t * 65 + e] = a[i] + bf2f(opb[t * 72 + e]); }
        }
        __syncthreads();
        { const int t = row, sub = w8; float v[8], ss = 0.f;
#pragma unroll
            for (int q = 0; q < 8; ++q) { v[q] = of[t * 65 + sub * 8 + q]; ss += v[q] * v[q]; }
            ss += shfl_xor_(ss, 1, lane); ss += shfl_xor_(ss, 2, lane); ss += shfl_xor_(ss, 4, lane);
            const float inv = rsqrtf(ss * (1.f / 64.f) + EPS);
            const float* nw = p.in[11] + l * 64 + sub * 8;
            unsigned o[4];
#pragma unroll
            for (int q = 0; q < 4; ++q) o[q] = pack2(v[2 * q] * inv * nw[2 * q] * siluf_(__uint_as_float(zraw[q] << 16)), v[2 * q + 1] * inv * nw[2 * q + 1] * siluf_(__uint_as_float(zraw[q] & 0xffff0000u)));
            *(u32x4*)brow = (u32x4){o[0], o[1], o[2], o[3]};
        }
        __syncthreads();
        return;
    }
    const float* cw = p.in[8] + (size_t)l * 4 * 768;
    float* fq = (float*)lds; float* fk = fq + 64 * 65; float* fv = fk + 64 * 65;
    float* Lf = (float*)lds;
    bf16_t* solT = (bf16_t*)(lds + 17408);
    bf16_t* attnb = (bf16_t*)(lds + 35840);
    bf16_t* qb = (bf16_t*)(lds + 54272); bf16_t* qdb = (bf16_t*)(lds + 63488); bf16_t* kb = (bf16_t*)(lds + 72704); bf16_t* kdT = (bf16_t*)(lds + 81920);
    bf16_t* raw = (bf16_t*)(lds + 54272);
    float* rhs = (float*)(lds + 91136);
    float* gc = (float*)(lds + 123904); float* beta = gc + 64; float* qsc = gc + 128; float* ksc = gc + 192; float* eg = gc + 256; float* ekd = gc + 320;
    float* cwl = (float*)(lds + 125440);
    float ext_b = 0.f, ext_a = 0.f;
    {
        u32x4 v[4];
#pragma unroll
        for (int i = 0; i < 4; ++i) { const int pc = tid + i * NTHR; v[i] = (u32x4){0u, 0u, 0u, 0u};
            if (pc < 67 * 24) { const int row = pc / 24, c = pc % 24, seg = c >> 3, w8 = c & 7, tt = row - 3;
                if (s0 + tt >= 0) v[i] = *(const u32x4*)(P + (ptrdiff_t)(trow0 + tt) * PW + PC_QKV + seg * 256 + h * 64 + w8 * 8); } }
        float cv[2];
#pragma unroll
        for (int i = 0; i < 2; ++i) { const int idx = tid + i * NTHR; cv[i] = 0.f; if (idx < 768) { const int k = idx / 192, c = idx % 192; cv[i] = cw[k * 768 + (c >> 6) * 256 + h * 64 + (c & 63)]; } }
        if (tid >= 128 && tid < 192) { ext_b = ext[(size_t)(trow0 + tid - 128) * 8 + h]; ext_a = ext[(size_t)(trow0 + tid - 128) * 8 + 4 + h]; }
#pragma unroll
        for (int i = 0; i < 4; ++i) { const int pc = tid + i * NTHR;
            if (pc < 67 * 24) { const int row = pc / 24, c = pc % 24, seg = c >> 3, w8 = c & 7; *(u32x4*)(raw + row * 216 + seg * 72 + w8 * 8) = v[i]; } }
#pragma unroll
        for (int i = 0; i < 2; ++i) { const int idx = tid + i * NTHR; if (idx < 768) cwl[idx] = cv[i]; }
    }
    __syncthreads();
    if (wid < 6) { const int which = wid >> 1, th = wid & 1, d = lane, c = which * 64 + d;
        const float w0 = cwl[c], w1 = cwl[192 + c], w2 = cwl[384 + c], w3 = cwl[576 + c];
        const bf16_t* rp = raw + which * 72 + d; float* fo = (which == 0 ? fq : (which == 1 ? fk : fv)) + d;
        float x0 = bf2f(rp[(th * 32) * 216]), x1 = bf2f(rp[(th * 32 + 1) * 216]), x2 = bf2f(rp[(th * 32 + 2) * 216]);
#pragma unroll 4
        for (int t = th * 32; t < th * 32 + 32; ++t) { const float x3 = bf2f(rp[(t + 3) * 216]);
            fo[t * 65] = siluf_(w0 * x0 + w1 * x1 + w2 * x2 + w3 * x3); x0 = x1; x1 = x2; x2 = x3; }
    }
    __syncthreads();
    if (tid < 128) { const int t = tid & 63, w = tid >> 6; const float* f = w ? fk : fq; float s = 0.f;
#pragma unroll 8
        for (int d = 0; d < 64; ++d) { const float v = f[t * 65 + d]; s += v * v; }
        (w ? ksc : qsc)[t] = rsqrtf(s + 1e-6f) * (w ? 1.f : 0.125f);
    } else if (tid < 192) { const int t = tid - 128;
        beta[t] = sigmoidf_(ext_b);
        gc[t] = -__expf(p.in[9][l * 4 + h]) * softplusf_(ext_a + p.in[10][l * 4 + h]);
    }
    __syncthreads();
    if (wid == 0) { float v = gc[lane];
#pragma unroll
        for (int o = 1; o < 64; o <<= 1) { const float u = shfl_up_(v, o, lane); if (lane >= o) v += u; }
        const float gl = __int_as_float(__builtin_amdgcn_readlane(__float_as_int(v), 63));
        gc[lane] = v; eg[lane] = __expf(v); ekd[lane] = __expf(gl - v); }
    __syncthreads();
    for (int idx = tid; idx < 2048; idx += NTHR) { const int t = idx >> 5, d = (idx & 31) * 2;
        const float e_ = eg[t], bt = beta[t], qs = qsc[t], ks = ksc[t], ek = ekd[t];
        const float q0 = fq[t * 65 + d] * qs, q1 = fq[t * 65 + d + 1] * qs, k0 = fk[t * 65 + d] * ks, k1 = fk[t * 65 + d + 1] * ks, v0 = fv[t * 65 + d], v1 = fv[t * 65 + d + 1];
        *(unsigned*)(qb + t * 72 + d) = pack2(q0, q1); *(unsigned*)(qdb + t * 72 + d) = pack2(q0 * e_, q1 * e_); *(unsigned*)(kb + t * 72 + d) = pack2(k0, k1);
        kdT[d * 72 + t] = f2bf(k0 * ek); kdT[(d + 1) * 72 + t] = f2bf(k1 * ek);
        *(f32x2*)(rhs + t * 128 + d) = (f32x2){bt * v0, bt * v1}; *(f32x2*)(rhs + t * 128 + 64 + d) = (f32x2){bt * e_ * k0, bt * e_ * k1}; }
    __syncthreads();
    { const int w = wid & 3, ti = w >> 1, tj = w & 1;
        f32x16 a = mma32((wid < 4 ? kb : qb) + ti * 32 * 72, kb + tj * 32 * 72, 64, zero16(), lane);
        if (wid < 4) {
#pragma unroll
            for (int i = 0; i < 16; ++i) { const int c = ti * 32 + crow(i, hh), m = tj * 32 + r; Lf[c * 68 + m] = (m < c) ? beta[c] * a[i] * __expf(gc[c] - gc[m]) : 0.f; }
        } else {
#pragma unroll
            for (int i = 0; i < 16; ++i) { const int c = ti * 32 + crow(i, hh), m = tj * 32 + r; attnb[c * 72 + m] = f2bf((m <= c) ? a[i] * __expf(gc[c] - gc[m]) : 0.f); }
        }
    }
    __syncthreads();
    { const int col = tid >> 2, part = tid & 3; float sl[16];
#pragma unroll
        for (int i = 0; i < 16; ++i) sl[i] = 0.f;
#pragma unroll
        for (int c = 0; c < 64; ++c) { float s = 0.f, s2 = 0.f;
#pragma unroll
            for (int k = 0; k < (c + 15) / 16; ++k) { const f32x4 lv = *(const f32x4*)(Lf + c * 68 + 16 * k + 4 * part);
                s += lv.x * sl[4 * k] + lv.z * sl[4 * k + 2]; s2 += lv.y * sl[4 * k + 1] + lv.w * sl[4 * k + 3]; }
            s += s2;
            s += __int_as_float(__builtin_amdgcn_update_dpp(0, __float_as_int(s), 0xB1, 0xf, 0xf, false));
            s += __int_as_float(__builtin_amdgcn_update_dpp(0, __float_as_int(s), 0x4E, 0xf, 0xf, false));
            const float val = rhs[c * 128 + col] - s;
            const int owner = (c >> 2) & 3, idx = (c >> 4) * 4 + (c & 3);
            sl[idx] = (part == owner) ? val : sl[idx]; }
#pragma unroll
        for (int i = 0; i < 16; i += 2) { const int c = 16 * (i >> 2) + 4 * part + (i & 3); *(unsigned*)(solT + col * 72 + c) = pack2(sl[i], sl[i + 1]); }
    }
    __syncthreads();
#pragma unroll
    for (int qq = 0; qq < 2; ++qq) { const int q = wid * 2 + qq, kind = q >> 2, ti = (q >> 1) & 1, tj = q & 1;
        f32x16 a = mma32((kind < 2 ? kdT : attnb) + ti * 32 * 72, solT + (((kind & 1) ? 0 : 64) + tj * 32) * 72, 64, zero16(), lane);
        if (kind == 0) { const float egl = eg[63];
#pragma unroll
            for (int i = 0; i < 16; ++i) { const int d = ti * 32 + crow(i, hh), j = tj * 32 + r; gmn[d * 64 + j] = (d == j ? egl : 0.f) - a[i]; }
        } else if (kind == 1) {
#pragma unroll
            for (int i = 0; i < 16; ++i) gmn[4096 + (ti * 32 + crow(i, hh)) * 64 + tj * 32 + r] = a[i];
        } else if (kind == 2) {
#pragma unroll
            for (int i = 0; i < 16; ++i) { const int t = ti * 32 + crow(i, hh), j = tj * 32 + r; BRp[(size_t)(trow0 + t) * D + 256 + h * 64 + j] = f2bf(bf2f(qdb[t * 72 + j]) - a[i]); }
        } else {
#pragma unroll
            for (int i = 0; i < 16; ++i) { const int t = ti * 32 + crow(i, hh), e = tj * 32 + r; BRp[(size_t)(trow0 + t) * D + h * 64 + e] = f2bf(a[i]); }
        }
    }
    __syncthreads();
}

template <int MODE>
DI void ret_item(const Ctx& p, int l, int item, char* lds) {
    const int tid = otid(p.wbase), lane = tid & 63, wid = p.wbase >> 6, r = lane & 31, hh = lane >> 5;
    const int bh = item >> 6, n = item & 63, b = bh >> 2, h = bh & 3;
    const int trow0 = b * SEQ + n * 64;
    const bf16_t* P = (const bf16_t*)(p.ws + WS_R);
    const int* pos = (const int*)p.in[1];
    float* kvg = (float*)(p.ws + WS_RKV) + (size_t)item * 4096;
    bf16_t* qb = (bf16_t*)lds; bf16_t* kb = qb + 64 * 72; bf16_t* qxb = kb + 64 * 72; bf16_t* vT = qxb + 64 * 72; bf16_t* prevT = vT + 64 * 72; bf16_t* sb = prevT + 64 * 72; bf16_t* kzT = sb + 64 * 72;
    float* of = (float*)(lds + 7 * 9216);
    const float lx_ = -exp2f(-5.f - (float)h), lg = lx_ * (1.f + lx_ * (-0.5f + lx_ * (0.33333333f + lx_ * (-0.25f + lx_ * (0.2f - lx_ * 0.16666667f)))));
    bf16_t* rawq = (bf16_t*)(lds + 81152); bf16_t* rawk = rawq + 64 * 72; float* posl = (float*)(lds + 81152 + 2 * 9216);
    u32x4 graw; f32x4 pv[2];
    {
        const int row = tid >> 3, w8 = tid & 7;
        const bf16_t* pr = P + (size_t)(trow0 + row) * PW + h * 64 + w8 * 8;
        u32x4 vq; if (MODE == 3) { vq = *(const u32x4*)(pr + PC_RQ); graw = *(const u32x4*)(pr + PC_RG); pv[0] = *(const f32x4*)(kvg + tid * 4); pv[1] = *(const f32x4*)(kvg + 2048 + tid * 4); }
        const u32x4 vk = *(const u32x4*)(pr + PC_RK), vv = *(const u32x4*)(pr + PC_RV);
        float ps = 0.f; if (tid < 64) ps = (float)pos[trow0 + tid];
        if (MODE == 3) *(u32x4*)(rawq + row * 72 + w8 * 8) = vq;
        *(u32x4*)(rawk + row * 72 + w8 * 8) = vk;
#pragma unroll
        for (int q = 0; q < 4; ++q) { vT[(w8 * 8 + 2 * q) * 72 + row] = (bf16_t)(vv[q] & 0xffffu); vT[(w8 * 8 + 2 * q + 1) * 72 + row] = (bf16_t)(vv[q] >> 16); }
        if (tid < 64) posl[tid] = ps;
        if (MODE == 3) {
#pragma unroll
            for (int i = 0; i < 2; ++i) { const int idx = (tid + i * NTHR) * 4, d = idx >> 6, e = idx & 63;
                prevT[e * 72 + d] = f2bf(pv[i].x); prevT[(e + 1) * 72 + d] = f2bf(pv[i].y); prevT[(e + 2) * 72 + d] = f2bf(pv[i].z); prevT[(e + 3) * 72 + d] = f2bf(pv[i].w); }
        }
    }
    __syncthreads();
    for (int idx = tid; idx < 64 * 32; idx += NTHR) { const int t = idx >> 5, i = idx & 31;
        const float freq = exp2f(-(float)i * (13.287712379549449f / 32.f));
        const float rev = posl[t] * freq * 0.15915494309189535f, fr_ = rev - floorf(rev); const float sn = __builtin_amdgcn_sinf(fr_), cs = __builtin_amdgcn_cosf(fr_);
        const float k1 = bf2f(rawk[t * 72 + i]), k2 = bf2f(rawk[t * 72 + 32 + i]);
        const float kr1 = (k1 * cs - k2 * sn) * 0.125f, kr2 = (k1 * sn + k2 * cs) * 0.125f;
        if (MODE == 1) { const float z = __expf((63.f - (float)t) * lg); kzT[i * 72 + t] = f2bf(kr1 * z); kzT[(32 + i) * 72 + t] = f2bf(kr2 * z); }
        else { const float q1 = bf2f(rawq[t * 72 + i]), q2 = bf2f(rawq[t * 72 + 32 + i]);
            const float qr1 = q1 * cs - q2 * sn, qr2 = q1 * sn + q2 * cs, xi = __expf(((float)t + 1.f) * lg);
            kb[t * 72 + i] = f2bf(kr1); kb[t * 72 + 32 + i] = f2bf(kr2);
            qb[t * 72 + i] = f2bf(qr1); qb[t * 72 + 32 + i] = f2bf(qr2);
            qxb[t * 72 + i] = f2bf(qr1 * xi); qxb[t * 72 + 32 + i] = f2bf(qr2 * xi); }
    }
    __syncthreads();
    if (MODE == 1) {
        if (wid < 4) { const int ti = wid >> 1, tj = wid & 1;
            f32x16 a = mma32(kzT + ti * 32 * 72, vT + tj * 32 * 72, 64, zero16(), lane);
#pragma unroll
            for (int i = 0; i < 16; ++i) kvg[(ti * 32 + crow(i, hh)) * 64 + tj * 32 + r] = a[i];
        }
        __syncthreads();
    } else {
        if (wid < 4) { const int ti = wid >> 1, tj = wid & 1;
            f32x16 a = mma32(qb + ti * 32 * 72, kb + tj * 32 * 72, 64, zero16(), lane);
#pragma unroll
            for (int i = 0; i < 16; ++i) { const int c = ti * 32 + crow(i, hh), m = tj * 32 + r; sb[c * 72 + m] = f2bf((m <= c) ? a[i] * __expf((float)(c - m) * lg) : 0.f); }
        }
        __syncthreads();
        if (wid < 4) { const int ti = wid >> 1, tj = wid & 1;
            f32x16 a = mma32(sb + ti * 32 * 72, vT + tj * 32 * 72, 64, zero16(), lane);
            a = mma32(qxb + ti * 32 * 72, prevT + tj * 32 * 72, 64, a, lane);
#pragma unroll
            for (int i = 0; i < 16; ++i) of[(ti * 32 + crow(i, hh)) * 65 + tj * 32 + r] = a[i];
        }
        __syncthreads();
        { const int t = tid >> 3, sub = tid & 7; float v[8], s1 = 0.f;
#pragma unroll
            for (int q = 0; q < 8; ++q) { v[q] = of[t * 65 + sub * 8 + q]; s1 += v[q]; }
            s1 += shfl_xor_(s1, 1, lane); s1 += shfl_xor_(s1, 2, lane); s1 += shfl_xor_(s1, 4, lane);
            const float mu = s1 * (1.f / 64.f); float s2 = 0.f;
#pragma unroll
            for (int q = 0; q < 8; ++q) { v[q] -= mu; s2 += v[q] * v[q]; }
            s2 += shfl_xor_(s2, 1, lane); s2 += shfl_xor_(s2, 2, lane); s2 += shfl_xor_(s2, 4, lane);
            const float inv = rsqrtf(s2 * (1.f / 64.f) + EPS);
            const float* nw = p.in[29] + l * 256 + h * 64 + sub * 8;
            unsigned o[4];
#pragma unroll
            for (int q = 0; q < 4; ++q) o[q] = pack2(v[2 * q] * inv * nw[2 * q] * siluf_(__uint_as_float(graw[q] << 16)), v[2 * q + 1] * inv * nw[2 * q + 1] * siluf_(__uint_as_float(graw[q] & 0xffff0000u)));
            *(u32x4*)((bf16_t*)(p.ws + WS_BR) + (size_t)(trow0 + t) * D + 768 + h * 64 + sub * 8) = (u32x4){o[0], o[1], o[2], o[3]};
        }
        __syncthreads();
    }
}

template <int MODE>
DI void s5_item(const Ctx& p, int l, int item, char* lds) {
    const int tid = otid(p.wbase), lane = tid & 63, wid = p.wbase >> 6, l15 = lane & 15, kq = lane >> 4;
    const int half = item & 1, bn = item >> 1, n = bn & 63, b = bn >> 6, g = half * 8 + wid, pp = lane;
    const int trow0 = b * SEQ + n * 64;
    const bf16_t* P = (const bf16_t*)(p.ws + WS_R);
    bf16_t* usb = (bf16_t*)lds;
    bf16_t* bbt = (bf16_t*)(lds + 17408) + wid * 256 * 16;
    bf16_t* buw = (bf16_t*)(lds + 17408) + wid * 16 * 128;
    bf16_t* Xw = (bf16_t*)(lds + 17408 + 32768) + wid * 16 * 136;
    f32x2* st = (f32x2*)(p.ws + WS_S5ST) + (size_t)bn * 1024 + g * 64 + pp;
    const int gi = l * 16 + g;
    const float dt = __expf(p.in[19][gi]);
    const float lr = p.in[12][gi * 64 + pp], li = p.in[13][gi * 64 + pp];
    const float mag = __expf(lr * dt); float sn, cs; sincosf(li * dt, &sn, &cs);
    const float ar = mag * cs, ai = mag * sn, den = lr * lr + li * li, nr = ar - 1.f;
    const float cr = (nr * lr + ai * li) / den, ci = (ai * lr - nr * li) / den;
    {
        const f32x4* brp = (const f32x4*)(p.in[14] + ((size_t)gi * 64 + pp) * 16); const f32x4* bip = (const f32x4*)(p.in[15] + ((size_t)gi * 64 + pp) * 16);
        float vr[16], vi[16];
#pragma unroll
        for (int q = 0; q < 4; ++q) { const f32x4 br_ = brp[q], bi_ = bip[q];
            vr[4 * q] = cr * br_.x - ci * bi_.x; vr[4 * q + 1] = cr * br_.y - ci * bi_.y; vr[4 * q + 2] = cr * br_.z - ci * bi_.z; vr[4 * q + 3] = cr * br_.w - ci * bi_.w;
            vi[4 * q] = cr * bi_.x + ci * br_.x; vi[4 * q + 1] = cr * bi_.y + ci * br_.y; vi[4 * q + 2] = cr * bi_.z + ci * br_.z; vi[4 * q + 3] = cr * bi_.w + ci * br_.w; }
        unsigned hr[8], hi_[8], lr_[8], li_[8];
#pragma unroll
        for (int q = 0; q < 8; ++q) { hr[q] = pack2(vr[2 * q], vr[2 * q + 1]); hi_[q] = pack2(vi[2 * q], vi[2 * q + 1]);
            lr_[q] = pack2(vr[2 * q] - __uint_as_float(hr[q] << 16), vr[2 * q + 1] - __uint_as_float(hr[q] & 0xffff0000u));
            li_[q] = pack2(vi[2 * q] - __uint_as_float(hi_[q] << 16), vi[2 * q + 1] - __uint_as_float(hi_[q] & 0xffff0000u)); }
        *(u32x4*)(bbt + pp * 16) = (u32x4){hr[0], hr[1], hr[2], hr[3]}; *(u32x4*)(bbt + pp * 16 + 8) = (u32x4){hr[4], hr[5], hr[6], hr[7]};
        *(u32x4*)(bbt + (64 + pp) * 16) = (u32x4){hi_[0], hi_[1], hi_[2], hi_[3]}; *(u32x4*)(bbt + (64 + pp) * 16 + 8) = (u32x4){hi_[4], hi_[5], hi_[6], hi_[7]};
        *(u32x4*)(bbt + (128 + pp) * 16) = (u32x4){lr_[0], lr_[1], lr_[2], lr_[3]}; *(u32x4*)(bbt + (128 + pp) * 16 + 8) = (u32x4){lr_[4], lr_[5], lr_[6], lr_[7]};
        *(u32x4*)(bbt + (192 + pp) * 16) = (u32x4){li_[0], li_[1], li_[2], li_[3]}; *(u32x4*)(bbt + (192 + pp) * 16 + 8) = (u32x4){li_[4], li_[5], li_[6], li_[7]};
    }
    {
        u32x4 v[2];
#pragma unroll
        for (int i = 0; i < 2; ++i) { const int pc = tid + i * NTHR, t = pc >> 4, c8 = pc & 15; v[i] = *(const u32x4*)(P + (size_t)(trow0 + t) * PW + PC_S5 + half * 128 + c8 * 8); }
#pragma unroll
        for (int i = 0; i < 2; ++i) { const int pc = tid + i * NTHR, t = pc >> 4, c8 = pc & 15; *(u32x4*)(usb + t * 136 + c8 * 8) = v[i]; }
    }
    __syncthreads();
    const bf16x8 zf = (bf16x8){0, 0, 0, 0, 0, 0, 0, 0};
    bf16x8 bfr[8], bfl[8];
#pragma unroll
    for (int tile = 0; tile < 8; ++tile) { bfr[tile] = (kq < 2) ? *(const bf16x8*)(bbt + (16 * tile + l15) * 16 + 8 * kq) : zf; bfl[tile] = (kq < 2) ? *(const bf16x8*)(bbt + (128 + 16 * tile + l15) * 16 + 8 * kq) : zf; }
    __syncthreads();
    float xr = 0.f, xi = 0.f;
    bf16x8 cf[4]; float dd = 0.f;
    if (MODE == 3) {
        const f32x2 s0 = *st; xr = s0.x; xi = s0.y;
        const float* crp = p.in[16] + ((size_t)gi * 16 + l15) * 64; const float* cip = p.in[17] + ((size_t)gi * 16 + l15) * 64;
#pragma unroll
        for (int s = 0; s < 4; ++s)
#pragma unroll
            for (int j = 0; j < 8; ++j) { const int k = 32 * s + 8 * kq + j; cf[s][j] = (short)f2bf(k < 64 ? crp[k] : -cip[k - 64]); }
        dd = p.in[18][gi * 16 + l15];
    }
    bf16_t* ygl = (bf16_t*)(p.ws + WS_YGL);
    for (int t16 = 0; t16 < 4; ++t16) {
        const bf16x8 af = (kq < 2) ? *(const bf16x8*)(usb + (t16 * 16 + l15) * 136 + wid * 16 + 8 * kq) : zf;
#pragma unroll
        for (int tile = 0; tile < 8; ++tile) { const f32x4 a4 = MFMA16(af, bfr[tile], MFMA16(af, bfl[tile], ((f32x4){0.f, 0.f, 0.f, 0.f})));
#pragma unroll
            for (int j = 0; j < 4; ++j) buw[(4 * kq + j) * 128 + 16 * tile + l15] = f2bf(a4[j]); }
        __syncthreads();
#pragma unroll 4
        for (int tt = 0; tt < 16; ++tt) {
            const float bur = bf2f(buw[tt * 128 + pp]), bui = bf2f(buw[tt * 128 + 64 + pp]);
            const float nxr = ar * xr - ai * xi + bur, nxi = ar * xi + ai * xr + bui; xr = nxr; xi = nxi;
            if (MODE == 3) { Xw[tt * 136 + pp] = f2bf(xr); Xw[tt * 136 + 64 + pp] = f2bf(xi); }
        }
        __syncthreads();
        if (MODE == 3) {
            f32x4 a4 = (f32x4){0.f, 0.f, 0.f, 0.f};
#pragma unroll
            for (int s = 0; s < 4; ++s) { const bf16x8 a = *(const bf16x8*)(Xw + l15 * 136 + 32 * s + 8 * kq); a4 = MFMA16(a, cf[s], a4); }
#pragma unroll
            for (int j = 0; j < 4; ++j) { const int t = t16 * 16 + 4 * kq + j;
                const float y = a4[j] + dd * bf2f(usb[t * 136 + wid * 16 + l15]);
                ygl[(size_t)(trow0 + t) * 256 + g * 16 + l15] = f2bf(geluf_(y)); }
            __syncthreads();
        }
    }
    if (MODE == 1) *st = (f32x2){xr, xi};
    __syncthreads();
}

template <int MODE>
DI void lru_item(const Ctx& p, int l, int item, char* lds) {
    const int tid = otid(p.wbase), lane = tid & 63, wid = p.wbase >> 6, sub = tid >> 8, ch = tid & 255, r = lane & 31, hh = lane >> 5;
    const int b = item >> 6, n64 = item & 63, trow0 = b * SEQ + n64 * 64, s0 = n64 * 64;
    const bf16_t* P = (const bf16_t*)(p.ws + WS_R);
    bf16_t* xcb = (bf16_t*)lds;
    bf16_t* rawy = (bf16_t*)(lds + 33792);
    bf16_t* gb = (bf16_t*)(lds + 67584);
    bf16_t* rawx = (bf16_t*)(lds + 67584);
    const int tl = sub * 32;
    const int nb = wid >> 1, gate = wid & 1;
    bf16x8 wf[2][4];
    { const bf16_t* wg = (const bf16_t*)(p.ws + WS_WLRU) + (size_t)(gate * 4 + nb) * 4096;
#pragma unroll
        for (int tj = 0; tj < 2; ++tj)
#pragma unroll
            for (int ks = 0; ks < 4; ++ks) wf[tj][ks] = *(const bf16x8*)(wg + (tj * 32 + r) * 64 + ks * 16 + 8 * hh); }
    {
        u32x4 vx[5], vy[4];
#pragma unroll
        for (int i = 0; i < 5; ++i) { const int pc = tid + i * NTHR; vx[i] = (u32x4){0u, 0u, 0u, 0u};
            if (pc < 67 * 32) { const int row = pc >> 5, c8 = pc & 31, tt = row - 3; if (s0 + tt >= 0) vx[i] = *(const u32x4*)(P + (ptrdiff_t)(trow0 + tt) * PW + PC_LX + c8 * 8); } }
        if (MODE == 3) {
#pragma unroll
            for (int i = 0; i < 4; ++i) { const int pc = tid + i * NTHR, row = pc >> 5, c8 = pc & 31; vy[i] = *(const u32x4*)(P + (size_t)(trow0 + row) * PW + PC_LY + c8 * 8); }
        }
#pragma unroll
        for (int i = 0; i < 5; ++i) { const int pc = tid + i * NTHR; if (pc < 67 * 32) { const int row = pc >> 5, c8 = pc & 31; *(u32x4*)(rawx + row * 264 + c8 * 8) = vx[i]; } }
        if (MODE == 3) {
#pragma unroll
            for (int i = 0; i < 4; ++i) { const int pc = tid + i * NTHR, row = pc >> 5, c8 = pc & 31; *(u32x4*)(rawy + row * 264 + c8 * 8) = vy[i]; }
        }
    }
    __syncthreads();
    {
        const float* cwp = p.in[22] + (size_t)l * 4 * 256 + ch;
        const float w0 = cwp[0], w1 = cwp[256], w2 = cwp[512], w3 = cwp[768], cb = p.in[23][l * 256 + ch];
        float x0 = bf2f(rawx[tl * 264 + ch]), x1 = bf2f(rawx[(tl + 1) * 264 + ch]), x2 = bf2f(rawx[(tl + 2) * 264 + ch]);
#pragma unroll 4
        for (int t = tl; t < tl + 32; ++t) { const float x3 = bf2f(rawx[(t + 3) * 264 + ch]);
            xcb[t * 264 + ch] = f2bf(w0 * x0 + w1 * x1 + w2 * x2 + w3 * x3 + cb); x0 = x1; x1 = x2; x2 = x3; }
    }
    __syncthreads();
    {
        const float* bias = p.in[gate ? 27 : 25] + l * 256 + nb * 64;
#pragma unroll
        for (int ti = 0; ti < 2; ++ti) {
            bf16x8 af[4];
#pragma unroll
            for (int ks = 0; ks < 4; ++ks) af[ks] = *(const bf16x8*)(xcb + (ti * 32 + r) * 264 + nb * 64 + ks * 16 + 8 * hh);
#pragma unroll
            for (int tj = 0; tj < 2; ++tj) { f32x16 a = zero16();
#pragma unroll
                for (int ks = 0; ks < 4; ++ks) a = MFMA32(af[ks], wf[tj][ks], a);
                const float bv = bias[tj * 32 + r];
#pragma unroll
                for (int i = 0; i < 16; ++i) gb[(gate * 64 + ti * 32 + crow(i, hh)) * 264 + nb * 64 + tj * 32 + r] = f2bf(sigmoidf_(a[i] + bv)); }
        }
    }
    __syncthreads();
    {
        const float sp = softplusf_(-p.in[28][l * 256 + ch]);
        f32x2* st = (f32x2*)(p.ws + WS_LRUST) + (size_t)(b * 128 + n64 * 2 + sub) * 256 + ch;
        float hst = 0.f, Acc = 1.f;
        if (MODE == 3) hst = (*st).x;
#pragma unroll 4
        for (int t = tl; t < tl + 32; ++t) {
            const float rg = bf2f(gb[t * 264 + ch]), ig = bf2f(gb[(64 + t) * 264 + ch]), xc = bf2f(xcb[t * 264 + ch]);
            const float la = -8.f * rg * sp, a = __expf(la), mult = __builtin_amdgcn_sqrtf(neg_expm1(2.f * la));
            hst = a * hst + xc * ig * mult;
            if (MODE == 1) Acc *= a;
            else { const float y = bf2f(rawy[t * 264 + ch]);
                ((bf16_t*)(p.ws + WS_BR))[(size_t)(trow0 + t) * D + 512 + ch] = f2bf(hst * geluf_(y)); }
        }
        if (MODE == 1) *st = (f32x2){Acc, hst};
    }
    __syncthreads();
}

constexpr int N_GDN = 2048, N_RET = 2048, N_S5 = 1024, N_LRU = 512;
template <int MODE>
DI void phase_mix(const Ctx& p, int l, char* lds) {
    constexpr int TOTAL = N_GDN + N_RET + N_S5 + N_LRU;
    for (int it = blockIdx.x; it < TOTAL; it += gridDim.x) {
        int r = it;
#ifndef NO_GDN
        if (r < N_GDN) { gdn_item<MODE>(p, l, r, lds); continue; }
#endif
        r -= N_GDN;
#ifndef NO_RET
        if (r < N_RET) { ret_item<MODE>(p, l, r, lds); continue; }
#endif
        r -= N_RET;
#ifndef NO_S5
        if (r < N_S5) { s5_item<MODE>(p, l, r, lds); continue; }
#endif
        r -= N_S5;
#ifndef NO_LRU
        lru_item<MODE>(p, l, r, lds);
#endif
    }
}
DI void phase_scan(const Ctx& p, int l, char* lds) {
    const int tid = otid(p.wbase), lane = tid & 63, wid = p.wbase >> 6;
    for (int it = blockIdx.x; it < 128 + 32 + 16 + 8; it += gridDim.x) {
        if (it < 128) {
            const int bh = it >> 2, qb = it & 3, kq = lane >> 4, col = lane & 15;
            float* base = (float*)(p.ws + WS_GMN) + (size_t)bh * 64 * 8192;
            f32x4* Sx = (f32x4*)lds;
            const bool act = wid < 4;
            const int d0 = 16 * wid + col;
            f32x4 mA[4][4], nN[4], sB[4], sOwn;
            const f32x4 z4 = (f32x4){0.f, 0.f, 0.f, 0.f};
#pragma unroll
            for (int q = 0; q < 4; ++q) { sB[q] = z4; nN[q] = z4;
#pragma unroll
                for (int s_ = 0; s_ < 4; ++s_) mA[s_][q] = z4; }
            sOwn = z4;
            if (act) {
#pragma unroll
                for (int s_ = 0; s_ < 4; ++s_) { const float* nx = base + (size_t)s_ * 8192;
#pragma unroll
                    for (int q = 0; q < 4; ++q) mA[s_][q] = *(const f32x4*)(nx + d0 * 64 + 16 * q + 4 * kq);
#pragma unroll
                    for (int r = 0; r < 4; ++r) nN[s_][r] = nx[4096 + (16 * wid + 4 * kq + r) * 64 + 16 * qb + col]; }
            }
            for (int n0 = 0; n0 < 64; n0 += 4) {
#pragma unroll
                for (int s_ = 0; s_ < 4; ++s_) { const int n = n0 + s_;
                    float* cur = base + (size_t)n * 8192;
                    if (act) {
                        f32x4 acc = nN[s_];
#pragma unroll
                        for (int r = 0; r < 4; ++r) cur[4096 + (16 * wid + 4 * kq + r) * 64 + 16 * qb + col] = sOwn[r];
#pragma unroll
                        for (int q = 0; q < 4; ++q)
#pragma unroll
                            for (int jj = 0; jj < 4; ++jj) acc = __builtin_amdgcn_mfma_f32_16x16x4f32(mA[s_][q][jj], sB[q][jj], acc, 0, 0, 0);
                        if (n + 4 < 64) { const float* nx = cur + 4 * 8192;
#pragma unroll
                            for (int q = 0; q < 4; ++q) mA[s_][q] = *(const f32x4*)(nx + d0 * 64 + 16 * q + 4 * kq);
#pragma unroll
                            for (int r = 0; r < 4; ++r) nN[s_][r] = nx[4096 + (16 * wid + 4 * kq + r) * 64 + 16 * qb + col]; }
                        sOwn = acc;
                        Sx[(n & 1) * 256 + wid * 64 + lane] = acc;
                    }
                    __syncthreads();
                    if (act) {
#pragma unroll
                        for (int q = 0; q < 4; ++q) sB[q] = Sx[(n & 1) * 256 + q * 64 + lane];
                    }
                }
            }
            __syncthreads();
        } else if (it < 160) {
            const int bh = it - 128, h = bh & 3;
            float gC = 1.f - exp2f(-5.f - (float)h); gC *= gC; gC *= gC; gC *= gC; gC *= gC; gC *= gC; gC *= gC;
            float* base = (float*)(p.ws + WS_RKV) + (size_t)bh * 64 * 4096 + tid * 8;
            f32x4 sA = (f32x4){0.f, 0.f, 0.f, 0.f}, sB = sA;
            for (int n = 0; n < 64; ++n) { float* cur = base + (size_t)n * 4096;
                const f32x4 kA = *(const f32x4*)cur, kB = *(const f32x4*)(cur + 4);
                *(f32x4*)cur = sA; *(f32x4*)(cur + 4) = sB;
                sA = sA * gC + kA; sB = sB * gC + kB; }
        } else if (it < 176) {
            const int r = it - 160, b = r >> 1, half = r & 1, g = half * 8 + wid, gi = l * 16 + g;
            const float dt = __expf(p.in[19][gi]), lr = p.in[12][gi * 64 + lane], li = p.in[13][gi * 64 + lane];
            const float mag = __expf(64.f * lr * dt); float sn, cs; sincosf(64.f * li * dt, &sn, &cs);
            const float ar = mag * cs, ai = mag * sn;
            f32x2* st = (f32x2*)(p.ws + WS_S5ST) + (size_t)b * 64 * 1024 + g * 64 + lane;
            float cr = 0.f, ci = 0.f;
            for (int n = 0; n < 64; ++n) { const f32x2 e = st[(size_t)n * 1024]; st[(size_t)n * 1024] = (f32x2){cr, ci};
                const float nr = ar * cr - ai * ci + e.x, ni = ar * ci + ai * cr + e.y; cr = nr; ci = ni; }
        } else {
            const int b = it - 176;
            if (tid < 256) { f32x2* st = (f32x2*)(p.ws + WS_LRUST) + (size_t)b * 128 * 256 + tid; float c = 0.f;
                for (int n = 0; n < 128; ++n) { const f32x2 e = st[(size_t)n * 256]; st[(size_t)n * 256] = (f32x2){c, 0.f}; c = e.x * c + e.y; } }
        }
    }
}

#define XB_TMO      128
#define XB_XCNT(j)  (256  + 64 * (j))
#define XB_XSUB(j)  (1280 + 64 * (j))
#define XB_XGEN(j)  (2304 + 64 * (j))
#define XB_TOP      3328
#define XB_TOPGEN   3392
#define XCD_BAR_WORDS 3456
#define XB_SPIN_CAP (1u << 18)
#define XB_LAS __attribute__((address_space(3)))

__device__ __forceinline__ unsigned xb_ld(unsigned* p)              { return __hip_atomic_load(p, __ATOMIC_RELAXED, __HIP_MEMORY_SCOPE_AGENT); }
__device__ __forceinline__ unsigned xb_add(unsigned* p, unsigned v) { return __hip_atomic_fetch_add(p, v, __ATOMIC_RELAXED, __HIP_MEMORY_SCOPE_AGENT); }
__device__ __forceinline__ unsigned xb_xcc_id() { return (unsigned)__builtin_amdgcn_s_getreg((3 << 11) | 20) & 0xFu; }
#define XB_SPIN(cond, bar) do { unsigned _sp = 0; while (cond) { __builtin_amdgcn_s_sleep(1); \
    if ((++_sp & 255u) == 0u) { if (xb_ld(&(bar)[XB_TMO])) break; if (_sp > XB_SPIN_CAP) { atomicAdd(&(bar)[XB_TMO], 1u); break; } } } } while (0)

struct XcdBarrier {
    unsigned* bar; unsigned x;
    volatile XB_LAS unsigned* st;
};

__device__ __forceinline__ XcdBarrier xcd_barrier_post(unsigned* bar, volatile XB_LAS unsigned* st, bool t0) {
    XcdBarrier b; b.bar = bar; b.x = xb_xcc_id(); b.st = st;
    if (t0) (void)xb_add(&bar[XB_XCNT(b.x)], 1u);
    return b;
}
__device__ __forceinline__ void xcd_barrier_complete(unsigned* bar, unsigned x, unsigned& nloc, unsigned& nx) {
    const unsigned G = gridDim.x * gridDim.y * gridDim.z;
    unsigned sum, cnt, mine, sp = 0u;
    for (;;) {
        sum = 0u; cnt = 0u; mine = 0u;
#pragma unroll
        for (unsigned j = 0; j < 16; ++j) { const unsigned c = xb_ld(&bar[XB_XCNT(j)]); sum += c; cnt += (c > 0u) ? 1u : 0u; mine = (j == x) ? c : mine; }
        if (sum == G) break;
        __builtin_amdgcn_s_sleep(1);
        if ((++sp & 255u) == 0u) { if (xb_ld(&bar[XB_TMO])) break; if (sp > XB_SPIN_CAP) { atomicAdd(&bar[XB_TMO], 1u); break; } }
    }
    nloc = mine > 0u ? mine : 1u; nx = cnt > 0u ? cnt : 1u;
}

__device__ __forceinline__ void xcd_barrier(const XcdBarrier& b, bool t0) {
    asm volatile("s_waitcnt vmcnt(0)" ::: "memory");
    __syncthreads();
    if (t0) {
        unsigned* bar = b.bar;
        __builtin_amdgcn_s_waitcnt(0);
        unsigned nloc = b.st[0], nx = b.st[1];
        if (nloc == 0u) { xcd_barrier_complete(bar, b.x, nloc, nx); b.st[0] = nloc; b.st[1] = nx; }
        const unsigned old = xb_add(&bar[XB_XSUB(b.x)], 1u);
        const unsigned gen = old / nloc;
        if (old + 1u == (gen + 1u) * nloc) {
            __builtin_amdgcn_fence(__ATOMIC_RELEASE, "agent");
            asm volatile("s_waitcnt vmcnt(0)" ::: "memory");
            const unsigned og = xb_add(&bar[XB_TOP], 1u);
            const unsigned tg = og / nx;
            if (og + 1u == (tg + 1u) * nx) xb_add(&bar[XB_TOPGEN], 1u);
            else XB_SPIN(xb_ld(&bar[XB_TOPGEN]) == tg, bar);
            __builtin_amdgcn_fence(__ATOMIC_ACQUIRE, "agent");
            xb_add(&bar[XB_XGEN(b.x)], 1u);
            asm volatile("s_waitcnt vmcnt(0)" ::: "memory");
        } else {
            XB_SPIN(xb_ld(&bar[XB_XGEN(b.x)]) == gen, bar);
            __builtin_amdgcn_fence(__ATOMIC_ACQUIRE, "agent");
            asm volatile("s_waitcnt vmcnt(0)" ::: "memory");
        }
    }
    __syncthreads();
}

#define CLOBBER_HI() asm volatile("" ::: "v72", "v73", "v74", "v75", "v76", "v77", "v78", "v79", "v80", "v81", "v82", "v83", "v84", "v85", "v86", "v87", "v88", "v89", "v90", "v91", "v92", "v93", "v94", "v95", "v96", "v97", "v98", "v99", "v100", "v101", "v102", "v103", "v104", "v105", "v106", "v107", "v108", "v109", "v110", "v111", "v112", "v113", "v114", "v115", "v116", "v117", "v118", "v119", "v120", "v121", "v122", "v123", "v124", "v125", "v126", "v127", "v128", "v129", "v130", "v131", "v132", "v133", "v134", "v135", "v136", "v137", "v138", "v139", "v140", "v141", "v142", "v143", "v144", "v145", "v146", "v147", "v148", "v149", "v150", "v151", "v152", "v153", "v154", "v155", "v156", "v157", "v158", "v159", "v160", "v161", "v162", "v163", "v164", "v165", "v166", "v167", "v168", "v169", "v170", "v171", "v172", "v173", "v174", "v175", "v176", "v177", "v178", "v179", "v180", "v181", "v182", "v183", "v184", "v185", "v186", "v187", "v188", "v189", "v190", "v191", "v192", "v193", "v194", "v195", "v196", "v197", "v198", "v199", "v200", "v201", "v202", "v203", "v204", "v205", "v206", "v207", "v208", "v209", "v210", "v211", "v212", "v213", "v214", "v215", "v216", "v217", "v218", "v219", "v220", "v221", "v222", "v223", "v224", "v225", "v226", "v227", "v228", "v229", "v230", "v231", "v232", "v233", "v234", "v235", "v236", "v237", "v238", "v239", "v240", "v241", "v242", "v243", "v244", "v245", "v246", "v247", "v248", "v249", "v250", "v251", "v252", "v253", "v254", "v255")
__global__ void __launch_bounds__(NTHR) mega(Params pp) {
    extern __shared__ __attribute__((aligned(16))) char lds[];
    cg::grid_group grid = cg::this_grid();
    Ctx p;
#pragma unroll
    for (int i = 0; i < 37; ++i) p.in[i] = pp.in[i];
    p.out = pp.out; p.ws = pp.ws; p.wbase = __builtin_amdgcn_readfirstlane((int)threadIdx.x & ~63);
    static_assert(XCD_BAR_WORDS_ == XCD_BAR_WORDS, "barrier words");
    volatile XB_LAS unsigned* xst = (volatile XB_LAS unsigned*)(XB_LAS unsigned char*)(lds + LDS_BAR_OFF);
    if (threadIdx.x == 0) { xst[0] = 0u; xst[1] = 0u; }
    __syncthreads();
    const XcdBarrier xb = xcd_barrier_post((unsigned*)(p.ws + WS_BAR), xst, threadIdx.x == 0);
#define GSYNC() do { xcd_barrier(xb, otid(p.wbase) == 0); CLOBBER_HI(); } while (0)
    for (int l = 0; l < DEPTH; ++l) {
        const float* xin = (l == 0) ? p.in[0] : p.out;
        const float* win_l = p.in[7] + (size_t)l * D * NIN;
        phase_wconv(p, l, lds);
        phase_norm<false>(p, xin, p.in[2] + l * D, win_l, lds);
        if (l == 0) { grid.sync(); CLOBBER_HI(); } else GSYNC();
        phase_ffn_a(p, (const bf16_t*)(p.ws + WS_WGU1), lds);
        GSYNC();
        phase_gemm_res(p, (const bf16_t*)(p.ws + WS_R), FF, (const bf16_t*)(p.ws + WS_WD1), xin, 0.5f, lds);
        GSYNC();
        phase_norm<true>(p, p.out, p.in[6] + l * D, win_l, lds);
        GSYNC();
        phase_proj(p, lds);
        GSYNC();
        phase_mix<1>(p, l, lds);
        GSYNC();
        phase_scan(p, l, lds);
        GSYNC();
        phase_mix<3>(p, l, lds);
        GSYNC();
        phase_glu(p, p.in[21] + l * 256, lds);
        GSYNC();
        phase_merge(p, lds);
        GSYNC();
        phase_gemm_res(p, (const bf16_t*)(p.ws + WS_R), D, (const bf16_t*)(p.ws + WS_WOUT), p.out, 1.0f, lds);
        GSYNC();
        phase_norm<false>(p, p.out, p.in[32] + l * D, win_l, lds);
        GSYNC();
        phase_ffn_a(p, (const bf16_t*)(p.ws + WS_WGU2), lds);
        GSYNC();
        phase_gemm_res(p, (const bf16_t*)(p.ws + WS_R), FF, (const bf16_t*)(p.ws + WS_WD2), p.out, 0.5f, lds);
        GSYNC();
    }
    phase_final_norm(p, p.in[36]);
}

extern "C" void kernel_launch(void* const* d_in, const int* in_sizes, int n_in, void* d_out, int out_size, void* d_ws, size_t ws_size, hipStream_t stream) {
    static int grid_blocks = 0;
    if (grid_blocks == 0) {
        if (n_in != 37 || ws_size < WS_END) { fprintf(stderr, "kernel_launch: unexpected n_in %d or ws_size %zu (< %zu)\n", n_in, ws_size, (size_t)WS_END); grid_blocks = -1; return; }
        int dev = 0, cus = 0, per_cu = 0;
        hipGetDevice(&dev);
        hipDeviceGetAttribute(&cus, hipDeviceAttributeMultiprocessorCount, dev);
        hipFuncSetAttribute((const void*)mega, hipFuncAttributeMaxDynamicSharedMemorySize, LDS_BYTES);
        hipOccupancyMaxActiveBlocksPerMultiprocessor(&per_cu, (const void*)mega, NTHR, LDS_BYTES);
        if (per_cu < 1) per_cu = 1;
        grid_blocks = cus * per_cu; if (grid_blocks > 256) grid_blocks = 256;
        fprintf(stderr, "kernel_launch: cus %d per_cu %d grid %d ws %zu need %zu\n", cus, per_cu, grid_blocks, ws_size, (size_t)WS_END);
    }
    if (grid_blocks < 0) return;
    Params p{};
    for (int i = 0; i < 37; ++i) p.in[i] = (const float*)d_in[i];
    p.out = (float*)d_out; p.ws = (char*)d_ws;
    (void)hipMemsetAsync((char*)d_ws + WS_BAR, 0, (size_t)XCD_BAR_WORDS_ * 4, stream);
    void* args[] = {&p};
    hipError_t e = hipLaunchCooperativeKernel((const void*)mega, dim3(grid_blocks), dim3(NTHR), args, LDS_BYTES, stream);
    if (e != hipSuccess) fprintf(stderr, "cooperative launch failed: %s (grid %d)\n", hipGetErrorString(e), grid_blocks);
}
```

```cpp
#include <hip/hip_runtime.h>
#include <hip/hip_cooperative_groups.h>
#include <cstdio>
namespace cg = cooperative_groups;

typedef unsigned short bf16_t;
typedef short bf16x8 __attribute__((ext_vector_type(8)));
typedef float f32x16 __attribute__((ext_vector_type(16)));
typedef float f32x4 __attribute__((ext_vector_type(4)));
typedef float f32x2 __attribute__((ext_vector_type(2)));
typedef unsigned u32x4 __attribute__((ext_vector_type(4)));
typedef unsigned u32x2 __attribute__((ext_vector_type(2)));
#define DI __device__ __forceinline__

constexpr int T = 32768, D = 1024, FF = 2816, SEQ = 4096, NB = 8, DEPTH = 4;
constexpr int NIN = 6920, PW = 2816;
constexpr int NTHR = 512;
constexpr int LDS_BYTES = 147456;
constexpr int XCD_BAR_WORDS_ = 3456;
constexpr int LDS_BAR_OFF = LDS_BYTES - 16;
constexpr float EPS = 1e-6f;
constexpr int PC_QKV = 0, PC_Z = 768, PC_S5 = 1024, PC_LX = 1280, PC_LY = 1536, PC_RQ = 1792, PC_RK = 2048, PC_RV = 2304, PC_RG = 2560;

constexpr size_t al256(size_t x) { return (x + 255) & ~(size_t)255; }
constexpr size_t WS_WGU1 = 0;
constexpr size_t WS_WD1 = WS_WGU1 + (size_t)2 * FF * D * 2;
constexpr size_t WS_WGU2 = WS_WD1 + (size_t)D * FF * 2;
constexpr size_t WS_WD2 = WS_WGU2 + (size_t)2 * FF * D * 2;
constexpr size_t WS_WIN = WS_WD2 + (size_t)D * FF * 2;
constexpr size_t WS_WGATE = WS_WIN + (size_t)PW * D * 2;
constexpr size_t WS_WBR = WS_WGATE + (size_t)4096 * D * 2;
constexpr size_t WS_WOUT = WS_WBR + (size_t)4 * D * 256 * 2;
constexpr size_t WS_WGLU = WS_WOUT + (size_t)D * D * 2;
constexpr size_t WS_XN = WS_WGLU + (size_t)256 * 256 * 2;
constexpr size_t WS_R = WS_XN + (size_t)T * D * 2;
constexpr size_t WS_BR = WS_R + (size_t)T * PW * 2;
constexpr size_t WS_EXT = WS_BR + (size_t)T * D * 2;
constexpr size_t WS_GMN = WS_EXT + (size_t)T * 8 * 4;
constexpr size_t WS_RKV = WS_GMN + (size_t)2048 * 8192 * 4;
constexpr size_t WS_S5ST = WS_RKV + (size_t)2048 * 4096 * 4;
constexpr size_t WS_LRUST = WS_S5ST + (size_t)NB * 64 * 1024 * 8;
constexpr size_t WS_YGL = WS_LRUST + (size_t)NB * 128 * 256 * 8;
constexpr size_t WS_BAR = WS_YGL + (size_t)T * 256 * 2;
constexpr size_t WS_WLRU = WS_BAR + (size_t)XCD_BAR_WORDS_ * 4;
constexpr size_t WS_END = WS_WLRU + (size_t)8 * 64 * 64 * 2;

struct Params { const float* in[37]; float* out; char* ws; };
struct Ctx { const float* in[37]; float* out; char* ws; int wbase; };

typedef __bf16 bf16v2 __attribute__((ext_vector_type(2)));
DI bf16_t f2bf(float f) { return __builtin_bit_cast(unsigned short, (__bf16)f); }
DI float bf2f(bf16_t b) { return __uint_as_float(((unsigned)b) << 16); }
DI unsigned pack2(float lo, float hi) { f32x2 v = {lo, hi}; return __builtin_bit_cast(unsigned, __builtin_convertvector(v, bf16v2)); }
DI float sigmoidf_(float x) { return __builtin_amdgcn_rcpf(1.f + __expf(-x)); }
DI float siluf_(float x) { return x * sigmoidf_(x); }
DI float log1p_small(float y) { return y < 0.01f ? y * (1.f - y * (0.5f - y * (0.33333333f - 0.25f * y))) : __logf(1.f + y); }
DI float softplusf_(float x) { return fmaxf(x, 0.f) + log1p_small(__expf(-fabsf(x))); }
DI float neg_expm1(float z) { return fabsf(z) < 0.5f ? -z * (1.f + z * (0.5f + z * (0.16666667f + z * (0.041666668f + z * (0.0083333338f + z * (0.0013888889f + z * 0.0001984127f)))))) : 1.f - __expf(z); }
DI float geluf_(float x) { const float u = 0.7978845608028654f * (x + 0.044715f * x * x * x); return x * (1.f - __builtin_amdgcn_rcpf(1.f + __expf(2.f * u))); }
DI float shfl_xor_(float v, int o, int lane) { return __int_as_float(__builtin_amdgcn_ds_bpermute((lane ^ o) << 2, __float_as_int(v))); }
DI float shfl_up_(float v, int o, int lane) { return __int_as_float(__builtin_amdgcn_ds_bpermute((lane - o) << 2, __float_as_int(v))); }
DI float wave_sum(float v, int lane) {
#pragma unroll
    for (int o = 1; o < 64; o <<= 1) v += shfl_xor_(v, o, lane);
    return v;
}
DI int otid(int wbase) { int l; asm volatile("v_mbcnt_lo_u32_b32 %0, -1, 0\n\tv_mbcnt_hi_u32_b32 %0, -1, %0" : "=v"(l)); return wbase + l; }
DI int crow(int i, int h) { return (i & 3) + 8 * (i >> 2) + 4 * h; }
#define MFMA32(a, b, c) __builtin_amdgcn_mfma_f32_32x32x16_bf16((a), (b), (c), 0, 0, 0)
#define MFMA16(a, b, c) __builtin_amdgcn_mfma_f32_16x16x32_bf16((a), (b), (c), 0, 0, 0)

DI f32x16 mma32(const bf16_t* A, const bf16_t* B, int K, f32x16 acc, int lane) {
    const int r = lane & 31, hh = lane >> 5;
    for (int k0 = 0; k0 < K; k0 += 16) {
        bf16x8 a = *(const bf16x8*)(A + r * 72 + k0 + 8 * hh);
        bf16x8 b = *(const bf16x8*)(B + r * 72 + k0 + 8 * hh);
        acc = MFMA32(a, b, acc);
    }
    return acc;
}
DI f32x16 zero16() { f32x16 z;
#pragma unroll
    for (int i = 0; i < 16; ++i) z[i] = 0.f;
    return z; }

namespace pg8 {
#define PG8_LAS __attribute__((address_space(3)))
constexpr int BM = 256, BK = 64, HALF = 128, HTB = HALF * BK * 2  , STAGE_BYTES = 8 * HTB, NXCD = 8, WGM = 8;

__host__ __device__ __forceinline__ int lds_byte(int r, int c) { const int st = (r >> 4) * 2 + (c >> 5), rr = r & 15, cc = c & 31, ob = rr * 64 + cc * 2; return st * 1024 + (ob ^ (((ob >> 9) & 1) << 5)); }
__host__ __device__ __forceinline__ void stage_rc(int b, int& R, int& C) { const int st = b / 1024, sb = b % 1024, swz = sb ^ (((sb >> 9) & 1) << 5); R = (st >> 1) * 16 + swz / 64; C = (st & 1) * 32 + (swz % 64) / 2; }
__host__ __device__ __forceinline__ int perm32(int rho) { const int n = rho >> 4, i = rho & 15; return 8 * (i >> 2) + 4 * n + (i & 3); }
struct Unit { int pm, pn; };
struct Gemm { const bf16_t* A; const bf16_t* Bt; int M, N, K, lda, ldb, wbase; };
struct StaticOrder {
    int nM, nN, nwg, G, c;
    __host__ __device__ void init(int M, int N, int G_, int c_) { nM = M / BM; nN = N / BM; nwg = nM * nN; G = G_; c = c_; }
    __host__ __device__ bool next(int i, Unit& u) const {
        const long L = (long)i * G + c; if (L >= nwg) return false;
        int wgid = (int)L; { const int q = nwg / NXCD, r = nwg % NXCD, xcd = wgid % NXCD, off = wgid / NXCD; wgid = (xcd < r ? xcd * (q + 1) : r * (q + 1) + (xcd - r) * q) + off; }
        const int nig = WGM * nN, gid = wgid / nig, fm = gid * WGM, gsz = (nM - fm) < WGM ? (nM - fm) : WGM;
        u.pm = fm + ((wgid % nig) % gsz); u.pn = (wgid % nig) / gsz; return true;
    }
    __device__ __forceinline__ void a_ready(const Unit&) const {}
    __device__ __forceinline__ void done(const Unit&) const {}
};
struct UnitX { int pm, pn, n, kind; };
template <class Epi, class Sched, bool STAMP = false>
__device__ __forceinline__ void gemm_phase(PG8_LAS unsigned char* lds, const Gemm g, const Sched& S, const Epi& E, unsigned long long* stamps) {
    const int tid = otid(g.wbase), wid = __builtin_amdgcn_readfirstlane(tid >> 6), lane = tid & 63, wr = wid >> 2, wc = wid & 3, fr = lane & 15, fq = lane >> 4;
    const int K = g.K, nt = K / BK;
    int ts_lo = 0, ts_hi = 0, nts = 0; const unsigned long long rt_entry = STAMP ? (unsigned long long)wall_clock64() : 0ull;
#define PG8_STAMP() do { if (STAMP && wid == 0 && nts < 64) { const unsigned long long _c = (unsigned long long)clock64(); \
        ts_lo = (lane == nts) ? (int)(unsigned)_c : ts_lo; ts_hi = (lane == nts) ? (int)(unsigned)(_c >> 32) : ts_hi; ++nts; } } while (0)
    PG8_STAMP();
    unsigned voffA[2], voffB[2];
#pragma unroll
    for (int i = 0; i < 2; ++i) { int R, C; stage_rc(tid * 16 + i * 8192, R, C); const int Rb = Epi::PERM ? ((R & ~31) + perm32(R & 31)) : R;
        voffA[i] = (unsigned)(R * g.lda + C) * 2u; voffB[i] = (unsigned)(Rb * g.ldb + C) * 2u; }
    const size_t kstep = (size_t)(BK * 2);
    const size_t hstepA = (size_t)HALF * g.lda * 2, hstepB = (size_t)HALF * g.ldb * 2;
    const size_t tstepA = 2 * hstepA, tstepB = 2 * hstepB;
    const unsigned ldsw = (unsigned)wid * 1024u;
    const int aoff = lds_byte(wr * 64 + fr, fq * 8), boff = lds_byte(wc * 32 + fr, fq * 8);
#define PG8_SA(b, h) (((b) * 2 + (h)) * HTB)
#define PG8_SB(b, h) ((4 + (b) * 2 + (h)) * HTB)
#define PG8_STAGE(bufoff, gbase, voff) do { _Pragma("unroll") for (int _i = 0; _i < 2; ++_i) \
        __builtin_amdgcn_global_load_lds((const unsigned*)((const char*)(gbase) + (voff)[_i]), (PG8_LAS unsigned*)(lds + (bufoff) + ldsw + _i * 8192), 16, 0, 0); } while (0)
#define PG8_LDA(dst, b, h) do { _Pragma("unroll") for (int m = 0; m < 4; ++m) _Pragma("unroll") for (int k = 0; k < 2; ++k) dst[m][k] = *(const PG8_LAS bf16x8*)(lds + PG8_SA(b, h) + aoff + m * 2048 + k * 1024); } while (0)
#define PG8_LDB(dst, b, h) do { _Pragma("unroll") for (int n = 0; n < 2; ++n) _Pragma("unroll") for (int k = 0; k < 2; ++k) dst[n][k] = *(const PG8_LAS bf16x8*)(lds + PG8_SB(b, h) + boff + n * 2048 + k * 1024); } while (0)
#define PG8_MMA(ai, bj, At, Bt) do { __builtin_amdgcn_s_setprio(1); _Pragma("unroll") for (int m = 0; m < 4; ++m) _Pragma("unroll") for (int n = 0; n < 2; ++n) _Pragma("unroll") for (int k = 0; k < 2; ++k) \
        acc[ai][bj][m][n] = __builtin_amdgcn_mfma_f32_16x16x32_bf16(Bt[n][k], At[m][k], acc[ai][bj][m][n], 0, 0, 0); __builtin_amdgcn_s_setprio(0); } while (0)
#define PG8_WAIT_V(n) asm volatile("s_waitcnt vmcnt(" #n ")" ::: "memory")
#define PG8_WAIT_L(n) asm volatile("s_waitcnt lgkmcnt(" #n ")" ::: "memory")
#define PG8_BAR __builtin_amdgcn_s_barrier()
#define PG8_SCHED __builtin_amdgcn_sched_barrier(0)
    Unit cur, nxt; int ui = 0;
    if (!S.next(0, cur)) return;
    f32x4 acc[2][2][4][2];
    if constexpr (Epi::INIT) E.init(acc, cur, wr, wc, fr, fq); else {
#pragma unroll
    for (int a = 0; a < 2; ++a)
#pragma unroll
        for (int b = 0; b < 2; ++b)
#pragma unroll
            for (int m = 0; m < 4; ++m)
#pragma unroll
                for (int n = 0; n < 2; ++n) acc[a][b][m][n] = (f32x4){0.f, 0.f, 0.f, 0.f};
    }
    bf16x8 At[4][2], B0[2][2], B1[2][2];
    const char* cA = (const char*)g.A + (size_t)cur.pm * tstepA; const char* cB = (const char*)g.Bt + (size_t)cur.pn * tstepB;
    S.a_ready(cur);
    PG8_STAGE(PG8_SB(0, 0), cB, voffB); PG8_STAGE(PG8_SA(0, 0), cA, voffA); PG8_STAGE(PG8_SB(0, 1), cB + hstepB, voffB); PG8_STAGE(PG8_SA(0, 1), cA + hstepA, voffA);
    if (wr == 1) PG8_BAR;
    PG8_WAIT_V(4); PG8_BAR;
    PG8_STAGE(PG8_SB(1, 0), cB + kstep, voffB); PG8_STAGE(PG8_SA(1, 0), cA + kstep, voffA); PG8_STAGE(PG8_SB(1, 1), cB + hstepB + kstep, voffB);
    PG8_WAIT_V(6); PG8_BAR;
    PG8_STAMP();
    for (;;) {
        const bool has_next = S.next(ui + 1, nxt);
        const char* nA = has_next ? (const char*)g.A + (size_t)nxt.pm * tstepA : cA; const char* nB = has_next ? (const char*)g.Bt + (size_t)nxt.pn * tstepB : cB;
        for (int t = 0; t < nt; t += 2) {
            const bool last = (t == nt - 2);
            const char* a1 = cA + (size_t)(t + 1) * kstep;
            const char* a2 = last ? nA : cA + (size_t)(t + 2) * kstep; const char* b2 = last ? nB : cB + (size_t)(t + 2) * kstep;
            const char* a3 = a2 + kstep; const char* b3 = b2 + kstep;
            if (last && has_next) S.a_ready(nxt);
            PG8_LDB(B0, 0, 0); PG8_SCHED; PG8_LDA(At, 0, 0); PG8_STAGE(PG8_SA(1, 1), a1 + hstepA, voffA);
            PG8_WAIT_L(8); PG8_BAR; PG8_WAIT_L(0); PG8_MMA(0, 0, At, B0); PG8_BAR; PG8_SCHED;
            PG8_LDB(B1, 0, 1); PG8_STAGE(PG8_SB(0, 0), b2, voffB);
            PG8_BAR; PG8_WAIT_L(0); PG8_MMA(0, 1, At, B1); PG8_BAR;
            PG8_LDA(At, 0, 1); PG8_STAGE(PG8_SA(0, 0), a2, voffA);
            PG8_BAR; PG8_WAIT_L(0); PG8_MMA(1, 0, At, B0); PG8_BAR; PG8_SCHED;
            PG8_STAGE(PG8_SB(0, 1), b2 + hstepB, voffB);
            PG8_WAIT_V(6); PG8_BAR; PG8_MMA(1, 1, At, B1); PG8_BAR;
            PG8_LDB(B0, 1, 0); PG8_SCHED; PG8_LDA(At, 1, 0); PG8_STAGE(PG8_SA(0, 1), a2 + hstepA, voffA);
            PG8_WAIT_L(8); PG8_BAR; PG8_WAIT_L(0); PG8_MMA(0, 0, At, B0); PG8_BAR; PG8_SCHED;
            PG8_LDB(B1, 1, 1); PG8_STAGE(PG8_SB(1, 0), b3, voffB);
            PG8_BAR; PG8_WAIT_L(0); PG8_MMA(0, 1, At, B1); PG8_BAR;
            PG8_LDA(At, 1, 1); PG8_STAGE(PG8_SA(1, 0), a3, voffA);
            PG8_BAR; PG8_WAIT_L(0); PG8_MMA(1, 0, At, B0); PG8_BAR; PG8_SCHED;
            PG8_STAGE(PG8_SB(1, 1), b3 + hstepB, voffB);
            PG8_WAIT_V(6); PG8_BAR; PG8_MMA(1, 1, At, B1); PG8_BAR;
        }
        PG8_STAMP();
        if constexpr (!Epi::AFTER_DRAIN) { int fr_e = fr, fq_e = fq; asm volatile("" : "+v"(fr_e), "+v"(fq_e)); E(acc, cur, wr, wc, fr_e, fq_e); S.done(cur); }
        PG8_STAMP();
        if (!has_next) break;
        if constexpr (Epi::INIT) E.init(acc, nxt, wr, wc, fr, fq); else {
#pragma unroll
        for (int a = 0; a < 2; ++a)
#pragma unroll
            for (int b = 0; b < 2; ++b)
#pragma unroll
                for (int m = 0; m < 4; ++m)
#pragma unroll
                    for (int n = 0; n < 2; ++n) acc[a][b][m][n] = (f32x4){0.f, 0.f, 0.f, 0.f};
        }
        cur = nxt; cA = nA; cB = nB; ++ui;
    }
    PG8_WAIT_V(0);
    if (wr == 0) PG8_BAR;
    PG8_BAR;
    if constexpr (Epi::AFTER_DRAIN) { E.fused(acc, cur, wr, wc, fr, fq, lds, wid, lane); S.done(cur); }
    PG8_STAMP();
    if (STAMP && wid == 0) { stamps[lane] = lane < nts ? (((unsigned long long)(unsigned)ts_hi << 32) | (unsigned)ts_lo) : 0ull;
        if (lane == 62) stamps[62] = rt_entry; if (lane == 63) stamps[63] = (unsigned long long)wall_clock64(); }
}
template <class Epi, class Sched>
__device__ __forceinline__ void gemm_phase_x(PG8_LAS unsigned char* lds, const Sched& S, const Epi& E) {
    constexpr bool STAMP = false; unsigned long long* stamps = nullptr;
    const int tid = otid(S.wbase), wid = __builtin_amdgcn_readfirstlane(tid >> 6), lane = tid & 63, wr = wid >> 2, wc = wid & 3, fr = lane & 15, fq = lane >> 4;
    int ts_lo = 0, ts_hi = 0, nts = 0; const unsigned long long rt_entry = STAMP ? (unsigned long long)wall_clock64() : 0ull;
#define PG8_STAMP() do { if (STAMP && wid == 0 && nts < 64) { const unsigned long long _c = (unsigned long long)clock64(); \
        ts_lo = (lane == nts) ? (int)(unsigned)_c : ts_lo; ts_hi = (lane == nts) ? (int)(unsigned)(_c >> 32) : ts_hi; ++nts; } } while (0)
    PG8_STAMP();
    unsigned voffA[2], voffB0[2], voffB1[2];
#pragma unroll
    for (int i = 0; i < 2; ++i) { int R, C; stage_rc(tid * 16 + i * 8192, R, C); const int Rb = Epi::PERM ? ((R & ~31) + perm32(R & 31)) : R;
        voffA[i] = (unsigned)(R * S.lda + C) * 2u; voffB0[i] = (unsigned)(Rb * S.ldb0 + C) * 2u; voffB1[i] = (unsigned)(Rb * S.ldb1 + C) * 2u; }
    const size_t kstep = (size_t)(BK * 2);
    const unsigned hstepA = (unsigned)HALF * S.lda * 2, hstepB0 = (unsigned)HALF * S.ldb0 * 2, hstepB1 = (unsigned)HALF * S.ldb1 * 2;
    const unsigned ldsw = (unsigned)wid * 1024u;
    const int aoff = lds_byte(wr * 64 + fr, fq * 8), boff = lds_byte(wc * 32 + fr, fq * 8);
#define PG8_SA(b, h) (((b) * 2 + (h)) * HTB)
#define PG8_SB(b, h) ((4 + (b) * 2 + (h)) * HTB)
#define PG8_STAGE(bufoff, gbase, voff) do { _Pragma("unroll") for (int _i = 0; _i < 2; ++_i) \
        __builtin_amdgcn_global_load_lds((const unsigned*)((const char*)(gbase) + (voff)[_i]), (PG8_LAS unsigned*)(lds + (bufoff) + ldsw + _i * 8192), 16, 0, 0); } while (0)
#define PG8_LDA(dst, b, h) do { _Pragma("unroll") for (int m = 0; m < 4; ++m) _Pragma("unroll") for (int k = 0; k < 2; ++k) dst[m][k] = *(const PG8_LAS bf16x8*)(lds + PG8_SA(b, h) + aoff + m * 2048 + k * 1024); } while (0)
#define PG8_LDB(dst, b, h) do { _Pragma("unroll") for (int n = 0; n < 2; ++n) _Pragma("unroll") for (int k = 0; k < 2; ++k) dst[n][k] = *(const PG8_LAS bf16x8*)(lds + PG8_SB(b, h) + boff + n * 2048 + k * 1024); } while (0)
#define PG8_MMA(ai, bj, At, Bt) do { __builtin_amdgcn_s_setprio(1); _Pragma("unroll") for (int m = 0; m < 4; ++m) _Pragma("unroll") for (int n = 0; n < 2; ++n) _Pragma("unroll") for (int k = 0; k < 2; ++k) \
        acc[ai][bj][m][n] = __builtin_amdgcn_mfma_f32_16x16x32_bf16(Bt[n][k], At[m][k], acc[ai][bj][m][n], 0, 0, 0); __builtin_amdgcn_s_setprio(0); } while (0)
#define PG8_WAIT_V(n) asm volatile("s_waitcnt vmcnt(" #n ")" ::: "memory")
#define PG8_WAIT_L(n) asm volatile("s_waitcnt lgkmcnt(" #n ")" ::: "memory")
#define PG8_BAR __builtin_amdgcn_s_barrier()
#define PG8_SCHED __builtin_amdgcn_sched_barrier(0)
    UnitX cur, nxt; int ui = 0;
    if (!S.next(0, cur)) return;
    f32x4 acc[2][2][4][2];
#pragma unroll
    for (int a = 0; a < 2; ++a)
#pragma unroll
        for (int b = 0; b < 2; ++b)
#pragma unroll
            for (int m = 0; m < 4; ++m)
#pragma unroll
                for (int n = 0; n < 2; ++n) acc[a][b][m][n] = (f32x4){0.f, 0.f, 0.f, 0.f};
    bf16x8 At[4][2], B0[2][2], B1[2][2];
    const char* cA = S.baseA(cur); const char* cB = S.baseB(cur);
    unsigned voffB[2] = {cur.kind ? voffB1[0] : voffB0[0], cur.kind ? voffB1[1] : voffB0[1]}; unsigned hstepB = cur.kind ? hstepB1 : hstepB0; int nt = S.nt(cur.kind);
    S.a_ready(cur);
    PG8_STAGE(PG8_SB(0, 0), cB, voffB); PG8_STAGE(PG8_SA(0, 0), cA, voffA); PG8_STAGE(PG8_SB(0, 1), cB + hstepB, voffB); PG8_STAGE(PG8_SA(0, 1), cA + hstepA, voffA);
    if (wr == 1) PG8_BAR;
    PG8_WAIT_V(4); PG8_BAR;
    PG8_STAGE(PG8_SB(1, 0), cB + kstep, voffB); PG8_STAGE(PG8_SA(1, 0), cA + kstep, voffA); PG8_STAGE(PG8_SB(1, 1), cB + hstepB + kstep, voffB);
    PG8_WAIT_V(6); PG8_BAR;
    PG8_STAMP();
    for (;;) {
        const bool has_next = S.next(ui + 1, nxt);
        const char* nA = has_next ? S.baseA(nxt) : cA; const char* nB = has_next ? S.baseB(nxt) : cB;
        const int nkind = has_next ? nxt.kind : cur.kind;
        const unsigned voffBn[2] = {nkind ? voffB1[0] : voffB0[0], nkind ? voffB1[1] : voffB0[1]}; const unsigned hstepBn = nkind ? hstepB1 : hstepB0;
        for (int t = 0; t < nt; t += 2) {
            const bool last = (t == nt - 2);
            const unsigned vB2[2] = {last ? voffBn[0] : voffB[0], last ? voffBn[1] : voffB[1]}; const unsigned hB2 = last ? hstepBn : hstepB;
            const char* a1 = cA + (size_t)(t + 1) * kstep;
            const char* a2 = last ? nA : cA + (size_t)(t + 2) * kstep; const char* b2 = last ? nB : cB + (size_t)(t + 2) * kstep;
            const char* a3 = a2 + kstep; const char* b3 = b2 + kstep;
            if (last && has_next) S.a_ready(nxt);
            PG8_LDB(B0, 0, 0); PG8_SCHED; PG8_LDA(At, 0, 0); PG8_STAGE(PG8_SA(1, 1), a1 + hstepA, voffA);
            PG8_WAIT_L(8); PG8_BAR; PG8_WAIT_L(0); PG8_MMA(0, 0, At, B0); PG8_BAR; PG8_SCHED;
            PG8_LDB(B1, 0, 1); PG8_STAGE(PG8_SB(0, 0), b2, vB2);
            PG8_BAR; PG8_WAIT_L(0); PG8_MMA(0, 1, At, B1); PG8_BAR;
            PG8_LDA(At, 0, 1); PG8_STAGE(PG8_SA(0, 0), a2, voffA);
            PG8_BAR; PG8_WAIT_L(0); PG8_MMA(1, 0, At, B0); PG8_BAR; PG8_SCHED;
            PG8_STAGE(PG8_SB(0, 1), b2 + hB2, vB2);
            PG8_WAIT_V(6); PG8_BAR; PG8_MMA(1, 1, At, B1); PG8_BAR;
            PG8_LDB(B0, 1, 0); PG8_SCHED; PG8_LDA(At, 1, 0); PG8_STAGE(PG8_SA(0, 1), a2 + hstepA, voffA);
            PG8_WAIT_L(8); PG8_BAR; PG8_WAIT_L(0); PG8_MMA(0, 0, At, B0); PG8_BAR; PG8_SCHED;
            PG8_LDB(B1, 1, 1); PG8_STAGE(PG8_SB(1, 0), b3, vB2);
            PG8_BAR; PG8_WAIT_L(0); PG8_MMA(0, 1, At, B1); PG8_BAR;
            PG8_LDA(At, 1, 1); PG8_STAGE(PG8_SA(1, 0), a3, voffA);
            PG8_BAR; PG8_WAIT_L(0); PG8_MMA(1, 0, At, B0); PG8_BAR; PG8_SCHED;
            PG8_STAGE(PG8_SB(1, 1), b3 + hB2, vB2);
            PG8_WAIT_V(6); PG8_BAR; PG8_MMA(1, 1, At, B1); PG8_BAR;
        }
        PG8_STAMP();
        if constexpr (!Epi::AFTER_DRAIN) { int fr_e = fr, fq_e = fq; asm volatile("" : "+v"(fr_e), "+v"(fq_e)); E(acc, cur, wr, wc, fr_e, fq_e); S.done(cur); }
        PG8_STAMP();
        if (!has_next) break;
#pragma unroll
        for (int a = 0; a < 2; ++a)
#pragma unroll
            for (int b = 0; b < 2; ++b)
#pragma unroll
                for (int m = 0; m < 4; ++m)
#pragma unroll
                    for (int n = 0; n < 2; ++n) acc[a][b][m][n] = (f32x4){0.f, 0.f, 0.f, 0.f};
        cur = nxt; cA = nA; cB = nB; ++ui; voffB[0] = voffBn[0]; voffB[1] = voffBn[1]; hstepB = hstepBn; nt = S.nt(cur.kind);
    }
    PG8_WAIT_V(0);
    if (wr == 0) PG8_BAR;
    PG8_BAR;
    if constexpr (Epi::AFTER_DRAIN) { E.fused(acc, cur, wr, wc, fr, fq, lds, wid, lane); S.done(cur); }
    PG8_STAMP();
    if (STAMP && wid == 0) { stamps[lane] = lane < nts ? (((unsigned long long)(unsigned)ts_hi << 32) | (unsigned)ts_lo) : 0ull;
        if (lane == 62) stamps[62] = rt_entry; if (lane == 63) stamps[63] = (unsigned long long)wall_clock64(); }
#undef PG8_STAMP
#undef PG8_SA
#undef PG8_SB
#undef PG8_STAGE
#undef PG8_LDA
#undef PG8_LDB
#undef PG8_MMA
#undef PG8_WAIT_V
#undef PG8_WAIT_L
#undef PG8_BAR
#undef PG8_SCHED
}
}

struct EpiFfnA {
    static constexpr bool PERM = true, AFTER_DRAIN = false, INIT = false;
    bf16_t* H;
    DI void operator()(const f32x4 (&acc)[2][2][4][2], const pg8::Unit& u, int wr, int wc, int fr, int fq) const {
        const int row0 = u.pm * 256 + wr * 64 + fr, col0 = u.pn * 128 + wc * 32 + 8 * fq;
#pragma unroll
        for (int ai = 0; ai < 2; ++ai)
#pragma unroll
            for (int m = 0; m < 4; ++m) { const f32x4 g0 = acc[ai][0][m][0], g1 = acc[ai][0][m][1], u0 = acc[ai][1][m][0], u1 = acc[ai][1][m][1];
                u32x4 w; w.x = pack2(siluf_(g0[0]) * u0[0], siluf_(g0[1]) * u0[1]); w.y = pack2(siluf_(g0[2]) * u0[2], siluf_(g0[3]) * u0[3]);
                w.z = pack2(siluf_(g1[0]) * u1[0], siluf_(g1[1]) * u1[1]); w.w = pack2(siluf_(g1[2]) * u1[2], siluf_(g1[3]) * u1[3]);
                *(u32x4*)(H + (size_t)(row0 + ai * 128 + m * 16) * FF + col0) = w; }
    }
};
struct EpiRes {
    static constexpr bool PERM = false, AFTER_DRAIN = false, INIT = true;
    float* out; const float* xin; int half;
    DI void init(f32x4 (&acc)[2][2][4][2], const pg8::Unit& u, int wr, int wc, int fr, int fq) const {
        const int row0 = u.pm * 256 + wr * 64 + fr, col0 = u.pn * 256 + wc * 32 + 4 * fq; const float rs = half ? 2.0f : 1.0f;
#pragma unroll
        for (int ai = 0; ai < 2; ++ai)
#pragma unroll
            for (int m = 0; m < 4; ++m) { const size_t o = (size_t)(row0 + ai * 128 + m * 16) * D + col0;
#pragma unroll
                for (int bj = 0; bj < 2; ++bj)
#pragma unroll
                    for (int n = 0; n < 2; ++n) acc[ai][bj][m][n] = *(const f32x4*)(xin + o + bj * 128 + n * 16) * rs; }
    }
    DI void operator()(const f32x4 (&acc)[2][2][4][2], const pg8::Unit& u, int wr, int wc, int fr, int fq) const {
        const int row0 = u.pm * 256 + wr * 64 + fr, col0 = u.pn * 256 + wc * 32 + 4 * fq; const float scale = half ? 0.5f : 1.0f;
#pragma unroll
        for (int ai = 0; ai < 2; ++ai)
#pragma unroll
            for (int m = 0; m < 4; ++m) { const size_t o = (size_t)(row0 + ai * 128 + m * 16) * D + col0;
#pragma unroll
                for (int bj = 0; bj < 2; ++bj)
#pragma unroll
                    for (int n = 0; n < 2; ++n) *(f32x4*)(out + o + bj * 128 + n * 16) = acc[ai][bj][m][n] * scale; }
    }
};
struct EpiBf {
    static constexpr bool PERM = true, AFTER_DRAIN = false, INIT = false;
    bf16_t* O; int ldc;
    DI void operator()(const f32x4 (&acc)[2][2][4][2], const pg8::Unit& u, int wr, int wc, int fr, int fq) const {
        const int row0 = u.pm * 256 + wr * 64 + fr, col0 = u.pn * 256 + wc * 32 + 8 * fq;
#pragma unroll
        for (int ai = 0; ai < 2; ++ai)
#pragma unroll
            for (int m = 0; m < 4; ++m)
#pragma unroll
                for (int bj = 0; bj < 2; ++bj) { const f32x4 v0 = acc[ai][bj][m][0], v1 = acc[ai][bj][m][1];
                    u32x4 w; w.x = pack2(v0[0], v0[1]); w.y = pack2(v0[2], v0[3]); w.z = pack2(v1[0], v1[1]); w.w = pack2(v1[2], v1[3]);
                    *(u32x4*)(O + (size_t)(row0 + ai * 128 + m * 16) * ldc + col0 + bj * 128) = w; }
    }
};
struct EpiGlu {
    static constexpr bool PERM = true, AFTER_DRAIN = false, INIT = false;
    const bf16_t* Y; bf16_t* BRo; const float* bias;
    DI void operator()(const f32x4 (&acc)[2][2][4][2], const pg8::Unit& u, int wr, int wc, int fr, int fq) const {
        const int row0 = u.pm * 256 + wr * 64 + fr, col0 = wc * 32 + 8 * fq;
#pragma unroll
        for (int ai = 0; ai < 2; ++ai)
#pragma unroll
            for (int m = 0; m < 4; ++m)
#pragma unroll
                for (int bj = 0; bj < 2; ++bj) { const int row = row0 + ai * 128 + m * 16, j = col0 + bj * 128;
                    const u32x4 yv = *(const u32x4*)(Y + (size_t)row * 256 + j);
                    const f32x4 b0 = *(const f32x4*)(bias + j), b1 = *(const f32x4*)(bias + j + 4);
                    const f32x4 v0 = acc[ai][bj][m][0] + b0, v1 = acc[ai][bj][m][1] + b1;
                    u32x4 w;
                    w.x = pack2(__uint_as_float(yv.x << 16) * sigmoidf_(v0[0]), __uint_as_float(yv.x & 0xffff0000u) * sigmoidf_(v0[1]));
                    w.y = pack2(__uint_as_float(yv.y << 16) * sigmoidf_(v0[2]), __uint_as_float(yv.y & 0xffff0000u) * sigmoidf_(v0[3]));
                    w.z = pack2(__uint_as_float(yv.z << 16) * sigmoidf_(v1[0]), __uint_as_float(yv.z & 0xffff0000u) * sigmoidf_(v1[1]));
                    w.w = pack2(__uint_as_float(yv.w << 16) * sigmoidf_(v1[2]), __uint_as_float(yv.w & 0xffff0000u) * sigmoidf_(v1[3]));
                    *(u32x4*)(BRo + (size_t)row * D + 256 + j) = w; }
    }
};
template <class Epi>
DI void run_gemm8(char* lds, int wbase, const bf16_t* A, int lda, const bf16_t* Bt, int ldb, int M, int N, int K, const Epi& E) {
    pg8::Gemm g; g.wbase = wbase; g.A = A; g.Bt = Bt; g.M = M; g.N = N; g.K = K; g.lda = lda; g.ldb = ldb;
    pg8::StaticOrder S; S.init(M, N, (int)gridDim.x, (int)blockIdx.x);
    pg8::gemm_phase<Epi, pg8::StaticOrder, false>((PG8_LAS unsigned char*)lds, g, S, E, nullptr);
}

DI void wconv_tile(int wbase, const float* src0, const float* src1, int ld, int mode, int c0, int K, bf16_t* dst, int tile, float* tl) {
    const int nkt = K / 64, tr = tile / nkt, tk = tile % nkt, R0 = tr * 64, k0 = tk * 64, tid = otid(wbase);
    {
        const int rl = tid & 63, kq = tid >> 6, R = R0 + rl;
        const float* src = src0; int col;
        if (mode == 0) col = R + c0;
        else if (mode == 1) { if ((R & 255) >= 128) src = src1; col = (R >> 8) * 128 + (R & 127); }
        else col = R < 1024 ? R : R + 8;
#pragma unroll
        for (int i = 0; i < 8; ++i) { const int k = kq + 8 * i; tl[k * 65 + rl] = src[(size_t)(k0 + k) * ld + col]; }
    }
    __syncthreads();
    {
        const int kp = tid & 31, rr = tid >> 5;
#pragma unroll
        for (int i = 0; i < 4; ++i) { const int R = rr + 16 * i;
            *(unsigned*)(dst + (size_t)(R0 + R) * K + k0 + 2 * kp) = pack2(tl[(2 * kp) * 65 + R], tl[(2 * kp + 1) * 65 + R]); }
    }
    __syncthreads();
}
DI void phase_wconv(const Ctx& p, int l, char* lds) {
    float* tl = (float*)lds;
    const float* g1 = p.in[3] + (size_t)l * D * FF; const float* u1 = p.in[4] + (size_t)l * D * FF; const float* d1 = p.in[5] + (size_t)l * FF * D;
    const float* g2 = p.in[33] + (size_t)l * D * FF; const float* u2 = p.in[34] + (size_t)l * D * FF; const float* d2 = p.in[35] + (size_t)l * FF * D;
    const float* win = p.in[7] + (size_t)l * D * NIN; const float* wbr = p.in[30] + (size_t)l * 4 * 256 * D; const float* wout = p.in[31] + (size_t)l * D * D;
    const float* wglu = p.in[20] + (size_t)l * 65536;
    constexpr int I_GU = 88 * 16, I_D = 16 * 44, I_IN = 44 * 16, I_GATE = 64 * 16, I_BR = 16 * 4, I_OUT = 16 * 16, I_GLU = 16, I_LRU = 8;
    constexpr int TOTAL = 2 * I_GU + 2 * I_D + I_IN + I_GATE + 4 * I_BR + I_OUT + I_GLU + I_LRU;
    for (int it = blockIdx.x; it < TOTAL; it += gridDim.x) {
        int r = it;
        if (r < I_GU) { wconv_tile(p.wbase, g1, u1, FF, 1, 0, D, (bf16_t*)(p.ws + WS_WGU1), r, tl); continue; } r -= I_GU;
        if (r < I_GU) { wconv_tile(p.wbase, g2, u2, FF, 1, 0, D, (bf16_t*)(p.ws + WS_WGU2), r, tl); continue; } r -= I_GU;
        if (r < I_D) { wconv_tile(p.wbase, d1, d1, D, 0, 0, FF, (bf16_t*)(p.ws + WS_WD1), r, tl); continue; } r -= I_D;
        if (r < I_D) { wconv_tile(p.wbase, d2, d2, D, 0, 0, FF, (bf16_t*)(p.ws + WS_WD2), r, tl); continue; } r -= I_D;
        if (r < I_IN) { wconv_tile(p.wbase, win, win, NIN, 2, 0, D, (bf16_t*)(p.ws + WS_WIN), r, tl); continue; } r -= I_IN;
        if (r < I_GATE) { wconv_tile(p.wbase, win, win, NIN, 0, 2824, D, (bf16_t*)(p.ws + WS_WGATE), r, tl); continue; } r -= I_GATE;
        if (r < 4 * I_BR) { const int n = r / I_BR; wconv_tile(p.wbase, wbr + (size_t)n * 256 * D, wbr, D, 0, 0, 256, (bf16_t*)(p.ws + WS_WBR) + (size_t)n * D * 256, r % I_BR, tl); continue; } r -= 4 * I_BR;
        if (r < I_OUT) { wconv_tile(p.wbase, wout, wout, D, 0, 0, D, (bf16_t*)(p.ws + WS_WOUT), r, tl); continue; } r -= I_OUT;
        if (r < I_GLU) { wconv_tile(p.wbase, wglu, wglu, 256, 0, 0, 256, (bf16_t*)(p.ws + WS_WGLU), r, tl); continue; } r -= I_GLU;
        { const int gate = r >> 2, nb = r & 3; const float* wsrc = p.in[gate ? 26 : 24] + ((size_t)(l * 4 + nb) * 64) * 64;
            wconv_tile(p.wbase, wsrc, wsrc, 64, 0, 0, 64, (bf16_t*)(p.ws + WS_WLRU) + (size_t)r * 4096, 0, tl); }
    }
}

template <bool EXT>
DI void phase_norm(const Ctx& p, const float* x, const float* nw, const float* win_l, char* lds) {
    const int tid = otid(p.wbase), lane = tid & 63, wid = p.wbase >> 6;
    bf16_t* xn = (bf16_t*)(p.ws + WS_XN);
    float* ext = (float*)(p.ws + WS_EXT);
    float* wext = (float*)lds;
    if (EXT) {
        for (int idx = tid; idx < 8192; idx += NTHR) { const int k = idx >> 3, c = idx & 7; wext[c * 1024 + k] = nw[k] * win_l[(size_t)k * NIN + 1024 + c]; }
        __syncthreads();
    }
    f32x4 nv[4];
#pragma unroll
    for (int j = 0; j < 4; ++j) nv[j] = *(const f32x4*)(nw + 4 * lane + 256 * j);
    constexpr int RPI = EXT ? 1 : 4;
    const int rstride = gridDim.x * 8;
    for (int row0 = blockIdx.x * 8 + wid; row0 < T; row0 += rstride * RPI) {
        f32x4 v[RPI][4]; float s[RPI];
#pragma unroll
        for (int q = 0; q < RPI; ++q) { const int row = row0 + q * rstride; s[q] = 0.f;
            if (row < T) {
#pragma unroll
                for (int j = 0; j < 4; ++j) v[q][j] = *(const f32x4*)(x + (size_t)row * D + 4 * lane + 256 * j);
            } else {
#pragma unroll
                for (int j = 0; j < 4; ++j) v[q][j] = (f32x4){0.f, 0.f, 0.f, 0.f};
            } }
#pragma unroll
        for (int q = 0; q < RPI; ++q) {
#pragma unroll
            for (int j = 0; j < 4; ++j) s[q] += v[q][j].x * v[q][j].x + v[q][j].y * v[q][j].y + v[q][j].z * v[q][j].z + v[q][j].w * v[q][j].w; }
#pragma unroll
        for (int o = 1; o < 64; o <<= 1) {
#pragma unroll
            for (int q = 0; q < RPI; ++q) s[q] += shfl_xor_(s[q], o, lane); }
#pragma unroll
        for (int q = 0; q < RPI; ++q) { const int row = row0 + q * rstride; if (row < T) {
            const float inv = rsqrtf(s[q] * (1.f / D) + EPS);
#pragma unroll
            for (int j = 0; j < 4; ++j) {
                u32x2 o; o.x = pack2(v[q][j].x * inv * nv[j].x, v[q][j].y * inv * nv[j].y); o.y = pack2(v[q][j].z * inv * nv[j].z, v[q][j].w * inv * nv[j].w);
                *(u32x2*)(xn + (size_t)row * D + 4 * lane + 256 * j) = o;
            }
            if (EXT) {
                float e[8];
#pragma unroll
                for (int c = 0; c < 8; ++c) { float a = 0.f;
#pragma unroll
                    for (int j = 0; j < 4; ++j) { const f32x4 w = *(const f32x4*)(wext + c * 1024 + 4 * lane + 256 * j); a += v[q][j].x * w.x + v[q][j].y * w.y + v[q][j].z * w.z + v[q][j].w * w.w; }
                    e[c] = a; }
#pragma unroll
                for (int o = 1; o < 64; o <<= 1) {
#pragma unroll
                    for (int c = 0; c < 8; ++c) e[c] += shfl_xor_(e[c], o, lane); }
                if (lane == 0) { *(f32x4*)(ext + (size_t)row * 8) = (f32x4){e[0] * inv, e[1] * inv, e[2] * inv, e[3] * inv}; *(f32x4*)(ext + (size_t)row * 8 + 4) = (f32x4){e[4] * inv, e[5] * inv, e[6] * inv, e[7] * inv}; }
            }
        } }
    }
    if (EXT) __syncthreads();
}
DI void phase_final_norm(const Ctx& p, const float* nw) {
    const int tid = otid(p.wbase), lane = tid & 63, wid = p.wbase >> 6;
    f32x4 nv[4];
#pragma unroll
    for (int j = 0; j < 4; ++j) nv[j] = *(const f32x4*)(nw + 4 * lane + 256 * j);
    constexpr int RPI = 4; const int rstride = gridDim.x * 8;
    for (int row0 = blockIdx.x * 8 + wid; row0 < T; row0 += rstride * RPI) {
        f32x4 v[RPI][4]; float s[RPI];
#pragma unroll
        for (int q = 0; q < RPI; ++q) { const int row = row0 + q * rstride; s[q] = 0.f;
#pragma unroll
            for (int j = 0; j < 4; ++j) v[q][j] = (row < T) ? *(const f32x4*)(p.out + (size_t)row * D + 4 * lane + 256 * j) : (f32x4){0.f, 0.f, 0.f, 0.f}; }
#pragma unroll
        for (int q = 0; q < RPI; ++q) {
#pragma unroll
            for (int j = 0; j < 4; ++j) s[q] += v[q][j].x * v[q][j].x + v[q][j].y * v[q][j].y + v[q][j].z * v[q][j].z + v[q][j].w * v[q][j].w; }
#pragma unroll
        for (int o = 1; o < 64; o <<= 1) {
#pragma unroll
            for (int q = 0; q < RPI; ++q) s[q] += shfl_xor_(s[q], o, lane); }
#pragma unroll
        for (int q = 0; q < RPI; ++q) { const int row = row0 + q * rstride; if (row < T) {
            const float inv = rsqrtf(s[q] * (1.f / D) + EPS);
#pragma unroll
            for (int j = 0; j < 4; ++j) *(f32x4*)(p.out + (size_t)row * D + 4 * lane + 256 * j) = (f32x4){v[q][j].x * inv * nv[j].x, v[q][j].y * inv * nv[j].y, v[q][j].z * inv * nv[j].z, v[q][j].w * inv * nv[j].w}; } }
    }
}

DI void phase_ffn_a(const Ctx& p, const bf16_t* wgu, char* lds) {
    EpiFfnA E; E.H = (bf16_t*)(p.ws + WS_R);
    run_gemm8(lds, p.wbase, (const bf16_t*)(p.ws + WS_XN), D, wgu, D, T, 2 * FF, D, E);
}
DI void phase_gemm_res(const Ctx& p, const bf16_t* A, int K, const bf16_t* Wt, const float* xin, float scale, char* lds) {
    EpiRes E; E.out = p.out; E.xin = xin; E.half = (scale == 0.5f) ? 1 : 0;
    run_gemm8(lds, p.wbase, A, K, Wt, K, T, D, K, E);
}
DI void phase_proj(const Ctx& p, char* lds) {
    EpiBf E; E.O = (bf16_t*)(p.ws + WS_R); E.ldc = PW;
    run_gemm8(lds, p.wbase, (const bf16_t*)(p.ws + WS_XN), D, (const bf16_t*)(p.ws + WS_WIN), D, T, PW, D, E);
}
DI void phase_glu(const Ctx& p, const float* bglu, char* lds) {
    EpiGlu E; E.Y = (const bf16_t*)(p.ws + WS_YGL); E.BRo = (bf16_t*)(p.ws + WS_BR); E.bias = bglu;
    run_gemm8(lds, p.wbase, (const bf16_t*)(p.ws + WS_YGL), 256, (const bf16_t*)(p.ws + WS_WGLU), 256, T, 256, 256, E);
}
struct MergeSched {
    pg8::StaticOrder so; const char* xn; const char* br; const char* wg; const char* wb; int lda, ldb0, ldb1, wbase;
    DI bool next(int i, pg8::UnitX& u) const { pg8::Unit t; if (!so.next(i >> 3, t)) return false; u.pm = t.pm; u.pn = t.pn; u.n = (i >> 1) & 3; u.kind = i & 1; return true; }
    DI const char* baseA(const pg8::UnitX& u) const { return (u.kind ? br + u.n * 512 : xn) + (size_t)u.pm * (256 * 1024 * 2); }
    DI const char* baseB(const pg8::UnitX& u) const { return u.kind ? wb + ((size_t)u.n * 1024 + u.pn * 256) * (256 * 2) : wg + ((size_t)u.n * 1024 + u.pn * 256) * (1024 * 2); }
    DI int nt(int kind) const { return kind ? 4 : 16; }
    DI void a_ready(const pg8::UnitX&) const {}
    DI void done(const pg8::UnitX&) const {}
};
struct EpiMerge {
    static constexpr bool PERM = true, AFTER_DRAIN = false;
    char* SG; char* SM; bf16_t* MG;
    DI void operator()(const f32x4 (&acc)[2][2][4][2], const pg8::UnitX& u, int wr, int wc, int fr, int fq) const {
        unsigned voff = (unsigned)(wr * 256 + wc * 64 + fq * 16 + fr) * 16u; asm volatile("" : "+v"(voff));
        if (u.kind == 0) {
#pragma unroll
            for (int ai = 0; ai < 2; ++ai)
#pragma unroll
                for (int bj = 0; bj < 2; ++bj)
#pragma unroll
                    for (int m = 0; m < 4; ++m) { const int idx = (ai * 2 + bj) * 4 + m; const f32x4 v0 = acc[ai][bj][m][0], v1 = acc[ai][bj][m][1];
                        u32x4 w; w.x = pack2(sigmoidf_(v0[0]), sigmoidf_(v0[1])); w.y = pack2(sigmoidf_(v0[2]), sigmoidf_(v0[3])); w.z = pack2(sigmoidf_(v1[0]), sigmoidf_(v1[1])); w.w = pack2(sigmoidf_(v1[2]), sigmoidf_(v1[3]));
                        *(u32x4*)(SG + (size_t)(idx * 8192) + voff) = w; }
        } else {
            const int row0 = u.pm * 256 + wr * 64 + fr, col0 = u.pn * 256 + wc * 32 + 8 * fq;
#pragma unroll
            for (int ai = 0; ai < 2; ++ai)
#pragma unroll
                for (int bj = 0; bj < 2; ++bj) {
                    u32x4 g[4]; f32x4 s0[4], s1[4];
#pragma unroll
                    for (int m = 0; m < 4; ++m) { const int idx = (ai * 2 + bj) * 4 + m; g[m] = *(const u32x4*)(SG + (size_t)(idx * 8192) + voff);
                        if (u.n > 0) { s0[m] = *(const f32x4*)(SM + (size_t)(2 * idx * 8192) + voff); s1[m] = *(const f32x4*)(SM + (size_t)((2 * idx + 1) * 8192) + voff); }
                        else { s0[m] = (f32x4){0.f, 0.f, 0.f, 0.f}; s1[m] = s0[m]; } }
#pragma unroll
                    for (int m = 0; m < 4; ++m) { const int idx = (ai * 2 + bj) * 4 + m;
                        f32x4 v0 = acc[ai][bj][m][0], v1 = acc[ai][bj][m][1];
                        v0[0] = v0[0] * __uint_as_float(g[m].x << 16) + s0[m][0]; v0[1] = v0[1] * __uint_as_float(g[m].x & 0xffff0000u) + s0[m][1];
                        v0[2] = v0[2] * __uint_as_float(g[m].y << 16) + s0[m][2]; v0[3] = v0[3] * __uint_as_float(g[m].y & 0xffff0000u) + s0[m][3];
                        v1[0] = v1[0] * __uint_as_float(g[m].z << 16) + s1[m][0]; v1[1] = v1[1] * __uint_as_float(g[m].z & 0xffff0000u) + s1[m][1];
                        v1[2] = v1[2] * __uint_as_float(g[m].w << 16) + s1[m][2]; v1[3] = v1[3] * __uint_as_float(g[m].w & 0xffff0000u) + s1[m][3];
                        if (u.n < 3) { *(f32x4*)(SM + (size_t)(2 * idx * 8192) + voff) = v0; *(f32x4*)(SM + (size_t)((2 * idx + 1) * 8192) + voff) = v1; }
                        else { u32x4 w; w.x = pack2(v0[0], v0[1]); w.y = pack2(v0[2], v0[3]); w.z = pack2(v1[0], v1[1]); w.w = pack2(v1[2], v1[3]);
                            *(u32x4*)(MG + (size_t)(row0 + ai * 128 + m * 16) * D + col0 + bj * 128) = w; } }
                }
        }
    }
};
DI void phase_merge(const Ctx& p, char* lds) {
    MergeSched S; S.so.init(T, D, (int)gridDim.x, (int)blockIdx.x);
    S.xn = p.ws + WS_XN; S.br = p.ws + WS_BR; S.wg = p.ws + WS_WGATE; S.wb = p.ws + WS_WBR; S.lda = D; S.ldb0 = D; S.ldb1 = 256; S.wbase = p.wbase;
    EpiMerge E; char* sc = p.ws + WS_GMN + (size_t)blockIdx.x * 393216;
    E.SG = sc; E.SM = sc + 131072; E.MG = (bf16_t*)(p.ws + WS_R);
    pg8::gemm_phase_x<EpiMerge, MergeSched>((PG8_LAS unsigned char*)lds, S, E);
}

template <int MODE>
DI void gdn_item(const Ctx& p, int l, int item, char* lds) {
    const int tid = otid(p.wbase), lane = tid & 63, wid = p.wbase >> 6, r = lane & 31, hh = lane >> 5;
    const int bh = item >> 6, n = item & 63, b = bh >> 2, h = bh & 3;
    const int trow0 = b * SEQ + n * 64, s0 = n * 64;
    const bf16_t* P = (const bf16_t*)(p.ws + WS_R);
    const float* ext = (const float*)(p.ws + WS_EXT);
    float* gmn = (float*)(p.ws + WS_GMN) + (size_t)item * 8192;
    bf16_t* BRp = (bf16_t*)(p.ws + WS_BR);
    if (MODE == 3) {
        bf16_t* SbT = (bf16_t*)lds; bf16_t* qpb = SbT + 64 * 72; bf16_t* opb = qpb + 64 * 72; float* of = (float*)(lds + 3 * 9216);
        const int row = tid >> 3, w8 = tid & 7;
        const f32x4 sv0 = *(const f32x4*)(gmn + 4096 + tid * 4), sv1 = *(const f32x4*)(gmn + 4096 + 2048 + tid * 4);
        bf16_t* brow = BRp + (size_t)(trow0 + row) * D + h * 64 + w8 * 8;
        const u32x4 qv = *(const u32x4*)(brow + 256), ov = *(const u32x4*)brow;
        const u32x4 zraw = *(const u32x4*)(P + (size_t)(trow0 + row) * PW + PC_Z + h * 64 + w8 * 8);
        { const int idx = tid * 4, d = idx >> 6, e = idx & 63;
            SbT[e * 72 + d] = f2bf(sv0.x); SbT[(e + 1) * 72 + d] = f2bf(sv0.y); SbT[(e + 2) * 72 + d] = f2bf(sv0.z); SbT[(e + 3) * 72 + d] = f2bf(sv0.w); }
        { const int idx = (tid + NTHR) * 4, d = idx >> 6, e = idx & 63;
            SbT[e * 72 + d] = f2bf(sv1.x); SbT[(e + 1) * 72 + d] = f2bf(sv1.y); SbT[(e + 2) * 72 + d] = f2bf(sv1.z); SbT[(e + 3) * 72 + d] = f2bf(sv1.w); }
        *(u32x4*)(qpb + row * 72 + w8 * 8) = qv; *(u32x4*)(opb + row * 72 + w8 * 8) = ov;
        __syncthreads();
        if (wid < 4) { const int ti = wid >> 1, tj = wid & 1;
            f32x16 a = mma32(qpb + ti * 32 * 72, SbT + tj * 32 * 72, 64, zero16(), lane);
#pragma unroll
            for (int i = 0; i < 16; ++i) { const int t = ti * 32 + crow(i, hh), e = tj * 32 + r; of[t * 65 + e] = a[i] + bf2f(opb[t * 72 + e]); }
        }
        __syncthreads();
        { const int t = row, sub = w8; float v[8], ss = 0.f;
#pragma unroll
            for (int q = 0; q < 8; ++q) { v[q] = of[t * 65 + sub * 8 + q]; ss += v[q] * v[q]; }
            ss += shfl_xor_(ss, 1, lane); ss += shfl_xor_(ss, 2, lane); ss += shfl_xor_(ss, 4, lane);
            const float inv = rsqrtf(ss * (1.f / 64.f) + EPS);
            const float* nw = p.in[11] + l * 64 + sub * 8;
            unsigned o[4];
#pragma unroll
            for (int q = 0; q < 4; ++q) o[q] = pack2(v[2 * q] * inv * nw[2 * q] * siluf_(__uint_as_float(zraw[q] << 16)), v[2 * q + 1] * inv * nw[2 * q + 1] * siluf_(__uint_as_float(zraw[q] & 0xffff0000u)));
            *(u32x4*)brow = (u32x4){o[0], o[1], o[2], o[3]};
        }
        __syncthreads();
        return;
    }
    const float* cw = p.in[8] + (size_t)l * 4 * 768;
    float* fq = (float*)lds; float* fk = fq + 64 * 65; float* fv = fk + 64 * 65;
    float* Lf = (float*)lds;
    bf16_t* solT = (bf16_t*)(lds + 17408);
    bf16_t* attnb = (bf16_t*)(lds + 35840);
    bf16_t* qb = (bf16_t*)(lds + 54272); bf16_t* qdb = (bf16_t*)(lds + 63488); bf16_t* kb = (bf16_t*)(lds + 72704); bf16_t* kdT = (bf16_t*)(lds + 81920);
    bf16_t* raw = (bf16_t*)(lds + 54272);
    float* rhs = (float*)(lds + 91136);
    float* gc = (float*)(lds + 123904); float* beta = gc + 64; float* qsc = gc + 128; float* ksc = gc + 192; float* eg = gc + 256; float* ekd = gc + 320;
    float* cwl = (float*)(lds + 125440);
    float ext_b = 0.f, ext_a = 0.f;
    {
        u32x4 v[4];
#pragma unroll
        for (int i = 0; i < 4; ++i) { const int pc = tid + i * NTHR; v[i] = (u32x4){0u, 0u, 0u, 0u};
            if (pc < 67 * 24) { const int row = pc / 24, c = pc % 24, seg = c >> 3, w8 = c & 7, tt = row - 3;
                if (s0 + tt >= 0) v[i] = *(const u32x4*)(P + (ptrdiff_t)(trow0 + tt) * PW + PC_QKV + seg * 256 + h * 64 + w8 * 8); } }
        float cv[2];
#pragma unroll
        for (int i = 0; i < 2; ++i) { const int idx = tid + i * NTHR; cv[i] = 0.f; if (idx < 768) { const int k = idx / 192, c = idx % 192; cv[i] = cw[k * 768 + (c >> 6) * 256 + h * 64 + (c & 63)]; } }
        if (tid >= 128 && tid < 192) { ext_b = ext[(size_t)(trow0 + tid - 128) * 8 + h]; ext_a = ext[(size_t)(trow0 + tid - 128) * 8 + 4 + h]; }
#pragma unroll
        for (int i = 0; i < 4; ++i) { const int pc = tid + i * NTHR;
            if (pc < 67 * 24) { const int row = pc / 24, c = pc % 24, seg = c >> 3, w8 = c & 7; *(u32x4*)(raw + row * 216 + seg * 72 + w8 * 8) = v[i]; } }
#pragma unroll
        for (int i = 0; i < 2; ++i) { const int idx = tid + i * NTHR; if (idx < 768) cwl[idx] = cv[i]; }
    }
    __syncthreads();
    if (wid < 6) { const int which = wid >> 1, th = wid & 1, d = lane, c = which * 64 + d;
        const float w0 = cwl[c], w1 = cwl[192 + c], w2 = cwl[384 + c], w3 = cwl[576 + c];
        const bf16_t* rp = raw + which * 72 + d; float* fo = (which == 0 ? fq : (which == 1 ? fk : fv)) + d;
        float x0 = bf2f(rp[(th * 32) * 216]), x1 = bf2f(rp[(th * 32 + 1) * 216]), x2 = bf2f(rp[(th * 32 + 2) * 216]);
#pragma unroll 4
        for (int t = th * 32; t < th * 32 + 32; ++t) { const float x3 = bf2f(rp[(t + 3) * 216]);
            fo[t * 65] = siluf_(w0 * x0 + w1 * x1 + w2 * x2 + w3 * x3); x0 = x1; x1 = x2; x2 = x3; }
    }
    __syncthreads();
    if (tid < 128) { const int t = tid & 63, w = tid >> 6; const float* f = w ? fk : fq; float s = 0.f;
#pragma unroll 8
        for (int d = 0; d < 64; ++d) { const float v = f[t * 65 + d]; s += v * v; }
        (w ? ksc : qsc)[t] = rsqrtf(s + 1e-6f) * (w ? 1.f : 0.125f);
    } else if (tid < 192) { const int t = tid - 128;
        beta[t] = sigmoidf_(ext_b);
        gc[t] = -__expf(p.in[9][l * 4 + h]) * softplusf_(ext_a + p.in[10][l * 4 + h]);
    }
    __syncthreads();
    if (wid == 0) { float v = gc[lane];
#pragma unroll
        for (int o = 1; o < 64; o <<= 1) { const float u = shfl_up_(v, o, lane); if (lane >= o) v += u; }
        const float gl = __int_as_float(__builtin_amdgcn_readlane(__float_as_int(v), 63));
        gc[lane] = v; eg[lane] = __expf(v); ekd[lane] = __expf(gl - v); }
    __syncthreads();
    for (int idx = tid; idx < 4096; idx += NTHR) { const int t = idx >> 6, d = idx & 63;
        const float e_ = eg[t], bt = beta[t];
        const float qv = fq[t * 65 + d] * qsc[t], kv = fk[t * 65 + d] * ksc[t], vv = fv[t * 65 + d];
        qb[t * 72 + d] = f2bf(qv); qdb[t * 72 + d] = f2bf(qv * e_); kb[t * 72 + d] = f2bf(kv); kdT[d * 72 + t] = f2bf(kv * ekd[t]);
        rhs[t * 128 + d] = bt * vv; rhs[t * 128 + 64 + d] = bt * e_ * kv; }
    __syncthreads();
    { const int w = wid & 3, ti = w >> 1, tj = w & 1;
        f32x16 a = mma32((wid < 4 ? kb : qb) + ti * 32 * 72, kb + tj * 32 * 72, 64, zero16(), lane);
        if (wid < 4) {
#pragma unroll
            for (int i = 0; i < 16; ++i) { const int c = ti * 32 + crow(i, hh), m = tj * 32 + r; Lf[c * 68 + m] = (m < c) ? beta[c] * a[i] * __expf(gc[c] - gc[m]) : 0.f; }
        } else {
#pragma unroll
            for (int i = 0; i < 16; ++i) { const int c = ti * 32 + crow(i, hh), m = tj * 32 + r; attnb[c * 72 + m] = f2bf((m <= c) ? a[i] * __expf(gc[c] - gc[m]) : 0.f); }
        }
    }
    __syncthreads();
    { const int col = tid >> 2, part = tid & 3; float sl[16];
#pragma unroll
        for (int i = 0; i < 16; ++i) sl[i] = 0.f;
#pragma unroll
        for (int c = 0; c < 64; ++c) { float s = 0.f, s2 = 0.f;
#pragma unroll
            for (int k = 0; k < (c + 15) / 16; ++k) { const f32x4 lv = *(const f32x4*)(Lf + c * 68 + 16 * k + 4 * part);
                s += lv.x * sl[4 * k] + lv.z * sl[4 * k + 2]; s2 += lv.y * sl[4 * k + 1] + lv.w * sl[4 * k + 3]; }
            s += s2;
            s += __int_as_float(__builtin_amdgcn_update_dpp(0, __float_as_int(s), 0xB1, 0xf, 0xf, false));
            s += __int_as_float(__builtin_amdgcn_update_dpp(0, __float_as_int(s), 0x4E, 0xf, 0xf, false));
            const float val = rhs[c * 128 + col] - s;
            const int owner = (c >> 2) & 3, idx = (c >> 4) * 4 + (c & 3);
            sl[idx] = (part == owner) ? val : sl[idx]; }
#pragma unroll
        for (int i = 0; i < 16; i += 2) { const int c = 16 * (i >> 2) + 4 * part + (i & 3); *(unsigned*)(solT + col * 72 + c) = pack2(sl[i], sl[i + 1]); }
    }
    __syncthreads();
#pragma unroll
    for (int qq = 0; qq < 2; ++qq) { const int q = wid * 2 + qq, kind = q >> 2, ti = (q >> 1) & 1, tj = q & 1;
        f32x16 a = mma32((kind < 2 ? kdT : attnb) + ti * 32 * 72, solT + (((kind & 1) ? 0 : 64) + tj * 32) * 72, 64, zero16(), lane);
        if (kind == 0) { const float egl = eg[63];
#pragma unroll
            for (int i = 0; i < 16; ++i) { const int d = ti * 32 + crow(i, hh), j = tj * 32 + r; gmn[d * 64 + j] = (d == j ? egl : 0.f) - a[i]; }
        } else if (kind == 1) {
#pragma unroll
            for (int i = 0; i < 16; ++i) gmn[4096 + (ti * 32 + crow(i, hh)) * 64 + tj * 32 + r] = a[i];
        } else if (kind == 2) {
#pragma unroll
            for (int i = 0; i < 16; ++i) { const int t = ti * 32 + crow(i, hh), j = tj * 32 + r; BRp[(size_t)(trow0 + t) * D + 256 + h * 64 + j] = f2bf(bf2f(qdb[t * 72 + j]) - a[i]); }
        } else {
#pragma unroll
            for (int i = 0; i < 16; ++i) { const int t = ti * 32 + crow(i, hh), e = tj * 32 + r; BRp[(size_t)(trow0 + t) * D + h * 64 + e] = f2bf(a[i]); }
        }
    }
    __syncthreads();
}

struct RetRegs { u32x4 vq, graw, vk, vv; f32x4 pv0, pv1; float ps; };
template <int MODE>
DI void ret_load(const Ctx& p, int item, RetRegs& rr) {
    const int tid = otid(p.wbase);
    const int bh = item >> 6, n = item & 63, b = bh >> 2, h = bh & 3, trow0 = b * SEQ + n * 64, row = tid >> 3, w8 = tid & 7;
    const bf16_t* pr = (const bf16_t*)(p.ws + WS_R) + (size_t)(trow0 + row) * PW + h * 64 + w8 * 8;
    const float* kvg = (const float*)(p.ws + WS_RKV) + (size_t)item * 4096;
    if (MODE == 3) { rr.vq = *(const u32x4*)(pr + PC_RQ); rr.graw = *(const u32x4*)(pr + PC_RG); rr.pv0 = *(const f32x4*)(kvg + tid * 4); rr.pv1 = *(const f32x4*)(kvg + 2048 + tid * 4); }
    rr.vk = *(const u32x4*)(pr + PC_RK); rr.vv = *(const u32x4*)(pr + PC_RV);
    rr.ps = 0.f; if (tid < 64) rr.ps = (float)((const int*)p.in[1])[trow0 + tid];
}
template <int MODE>
DI void ret_item(const Ctx& p, int l, int item, char* lds, const RetRegs& rr) {
    const int tid = otid(p.wbase), lane = tid & 63, wid = p.wbase >> 6, r = lane & 31, hh = lane >> 5;
    const int bh = item >> 6, n = item & 63, b = bh >> 2, h = bh & 3;
    const int trow0 = b * SEQ + n * 64;
    const bf16_t* P = (const bf16_t*)(p.ws + WS_R);
    const int* pos = (const int*)p.in[1];
    float* kvg = (float*)(p.ws + WS_RKV) + (size_t)item * 4096;
    bf16_t* qb = (bf16_t*)lds; bf16_t* kb = qb + 64 * 72; bf16_t* qxb = kb + 64 * 72; bf16_t* vT = qxb + 64 * 72; bf16_t* prevT = vT + 64 * 72; bf16_t* sb = prevT + 64 * 72; bf16_t* kzT = sb + 64 * 72;
    float* of = (float*)(lds + 7 * 9216);
    const float lx_ = -exp2f(-5.f - (float)h), lg = lx_ * (1.f + lx_ * (-0.5f + lx_ * (0.33333333f + lx_ * (-0.25f + lx_ * (0.2f - lx_ * 0.16666667f)))));
    bf16_t* rawq = (bf16_t*)(lds + 81152); bf16_t* rawk = rawq + 64 * 72; float* posl = (float*)(lds + 81152 + 2 * 9216);
    const u32x4 graw = rr.graw;
    {
        const int row = tid >> 3, w8 = tid & 7;
        const f32x4 pv[2] = {rr.pv0, rr.pv1};
        if (MODE == 3) *(u32x4*)(rawq + row * 72 + w8 * 8) = rr.vq;
        *(u32x4*)(rawk + row * 72 + w8 * 8) = rr.vk;
#pragma unroll
        for (int q = 0; q < 4; ++q) { vT[(w8 * 8 + 2 * q) * 72 + row] = (bf16_t)(rr.vv[q] & 0xffffu); vT[(w8 * 8 + 2 * q + 1) * 72 + row] = (bf16_t)(rr.vv[q] >> 16); }
        if (tid < 64) posl[tid] = rr.ps;
        if (MODE == 3) {
#pragma unroll
            for (int i = 0; i < 2; ++i) { const int idx = (tid + i * NTHR) * 4, d = idx >> 6, e = idx & 63;
                prevT[e * 72 + d] = f2bf(pv[i].x); prevT[(e + 1) * 72 + d] = f2bf(pv[i].y); prevT[(e + 2) * 72 + d] = f2bf(pv[i].z); prevT[(e + 3) * 72 + d] = f2bf(pv[i].w); }
        }
    }
    __syncthreads();
    for (int idx = tid; idx < 64 * 32; idx += NTHR) { const int t = idx >> 5, i = idx & 31;
        const float freq = exp2f(-(float)i * (13.287712379549449f / 32.f));
        const float rev = posl[t] * freq * 0.15915494309189535f, fr_ = rev - floorf(rev); const float sn = __builtin_amdgcn_sinf(fr_), cs = __builtin_amdgcn_cosf(fr_);
        const float k1 = bf2f(rawk[t * 72 + i]), k2 = bf2f(rawk[t * 72 + 32 + i]);
        const float kr1 = (k1 * cs - k2 * sn) * 0.125f, kr2 = (k1 * sn + k2 * cs) * 0.125f;
        if (MODE == 1) { const float z = __expf((63.f - (float)t) * lg); kzT[i * 72 + t] = f2bf(kr1 * z); kzT[(32 + i) * 72 + t] = f2bf(kr2 * z); }
        else { const float q1 = bf2f(rawq[t * 72 + i]), q2 = bf2f(rawq[t * 72 + 32 + i]);
            const float qr1 = q1 * cs - q2 * sn, qr2 = q1 * sn + q2 * cs, xi = __expf(((float)t + 1.f) * lg);
            kb[t * 72 + i] = f2bf(kr1); kb[t * 72 + 32 + i] = f2bf(kr2);
            qb[t * 72 + i] = f2bf(qr1); qb[t * 72 + 32 + i] = f2bf(qr2);
            qxb[t * 72 + i] = f2bf(qr1 * xi); qxb[t * 72 + 32 + i] = f2bf(qr2 * xi); }
    }
    __syncthreads();
    if (MODE == 1) {
        if (wid < 4) { const int ti = wid >> 1, tj = wid & 1;
            f32x16 a = mma32(kzT + ti * 32 * 72, vT + tj * 32 * 72, 64, zero16(), lane);
#pragma unroll
            for (int i = 0; i < 16; ++i) kvg[(ti * 32 + crow(i, hh)) * 64 + tj * 32 + r] = a[i];
        }
        __syncthreads();
    } else {
        if (wid < 4) { const int ti = wid >> 1, tj = wid & 1;
            f32x16 a = mma32(qb + ti * 32 * 72, kb + tj * 32 * 72, 64, zero16(), lane);
#pragma unroll
            for (int i = 0; i < 16; ++i) { const int c = ti * 32 + crow(i, hh), m = tj * 32 + r; sb[c * 72 + m] = f2bf((m <= c) ? a[i] * __expf((float)(c - m) * lg) : 0.f); }
        }
        __syncthreads();
        if (wid < 4) { const int ti = wid >> 1, tj = wid & 1;
            f32x16 a = mma32(sb + ti * 32 * 72, vT + tj * 32 * 72, 64, zero16(), lane);
            a = mma32(qxb + ti * 32 * 72, prevT + tj * 32 * 72, 64, a, lane);
#pragma unroll
            for (int i = 0; i < 16; ++i) of[(ti * 32 + crow(i, hh)) * 65 + tj * 32 + r] = a[i];
        }
        __syncthreads();
        { const int t = tid >> 3, sub = tid & 7; float v[8], s1 = 0.f;
#pragma unroll
            for (int q = 0; q < 8; ++q) { v[q] = of[t * 65 + sub * 8 + q]; s1 += v[q]; }
            s1 += shfl_xor_(s1, 1, lane); s1 += shfl_xor_(s1, 2, lane); s1 += shfl_xor_(s1, 4, lane);
            const float mu = s1 * (1.f / 64.f); float s2 = 0.f;
#pragma unroll
            for (int q = 0; q < 8; ++q) { v[q] -= mu; s2 += v[q] * v[q]; }
            s2 += shfl_xor_(s2, 1, lane); s2 += shfl_xor_(s2, 2, lane); s2 += shfl_xor_(s2, 4, lane);
            const float inv = rsqrtf(s2 * (1.f / 64.f) + EPS);
            const float* nw = p.in[29] + l * 256 + h * 64 + sub * 8;
            unsigned o[4];
#pragma unroll
            for (int q = 0; q < 4; ++q) o[q] = pack2(v[2 * q] * inv * nw[2 * q] * siluf_(__uint_as_float(graw[q] << 16)), v[2 * q + 1] * inv * nw[2 * q + 1] * siluf_(__uint_as_float(graw[q] & 0xffff0000u)));
            *(u32x4*)((bf16_t*)(p.ws + WS_BR) + (size_t)(trow0 + t) * D + 768 + h * 64 + sub * 8) = (u32x4){o[0], o[1], o[2], o[3]};
        }
        __syncthreads();
    }
}

template <int MODE>
DI void s5_item(const Ctx& p, int l, int item, char* lds) {
    const int tid = otid(p.wbase), lane = tid & 63, wid = p.wbase >> 6, l15 = lane & 15, kq = lane >> 4;
    const int half = item & 1, bn = item >> 1, n = bn & 63, b = bn >> 6, g = half * 8 + wid, pp = lane;
    const int trow0 = b * SEQ + n * 64;
    const bf16_t* P = (const bf16_t*)(p.ws + WS_R);
    bf16_t* usb = (bf16_t*)lds;
    bf16_t* bbt = (bf16_t*)(lds + 17408) + wid * 256 * 16;
    bf16_t* buw = (bf16_t*)(lds + 17408) + wid * 16 * 128;
    bf16_t* Xw = (bf16_t*)(lds + 17408 + 32768) + wid * 16 * 136;
    f32x2* st = (f32x2*)(p.ws + WS_S5ST) + (size_t)bn * 1024 + g * 64 + pp;
    const int gi = l * 16 + g;
    const float dt = __expf(p.in[19][gi]);
    const float lr = p.in[12][gi * 64 + pp], li = p.in[13][gi * 64 + pp];
    const float mag = __expf(lr * dt); float sn, cs; sincosf(li * dt, &sn, &cs);
    const float ar = mag * cs, ai = mag * sn, den = lr * lr + li * li, nr = ar - 1.f;
    const float cr = (nr * lr + ai * li) / den, ci = (ai * lr - nr * li) / den;
    {
        const f32x4* brp = (const f32x4*)(p.in[14] + ((size_t)gi * 64 + pp) * 16); const f32x4* bip = (const f32x4*)(p.in[15] + ((size_t)gi * 64 + pp) * 16);
        float vr[16], vi[16];
#pragma unroll
        for (int q = 0; q < 4; ++q) { const f32x4 br_ = brp[q], bi_ = bip[q];
            vr[4 * q] = cr * br_.x - ci * bi_.x; vr[4 * q + 1] = cr * br_.y - ci * bi_.y; vr[4 * q + 2] = cr * br_.z - ci * bi_.z; vr[4 * q + 3] = cr * br_.w - ci * bi_.w;
            vi[4 * q] = cr * bi_.x + ci * br_.x; vi[4 * q + 1] = cr * bi_.y + ci * br_.y; vi[4 * q + 2] = cr * bi_.z + ci * br_.z; vi[4 * q + 3] = cr * bi_.w + ci * br_.w; }
        unsigned hr[8], hi_[8], lr_[8], li_[8];
#pragma unroll
        for (int q = 0; q < 8; ++q) { hr[q] = pack2(vr[2 * q], vr[2 * q + 1]); hi_[q] = pack2(vi[2 * q], vi[2 * q + 1]);
            lr_[q] = pack2(vr[2 * q] - __uint_as_float(hr[q] << 16), vr[2 * q + 1] - __uint_as_float(hr[q] & 0xffff0000u));
            li_[q] = pack2(vi[2 * q] - __uint_as_float(hi_[q] << 16), vi[2 * q + 1] - __uint_as_float(hi_[q] & 0xffff0000u)); }
        *(u32x4*)(bbt + pp * 16) = (u32x4){hr[0], hr[1], hr[2], hr[3]}; *(u32x4*)(bbt + pp * 16 + 8) = (u32x4){hr[4], hr[5], hr[6], hr[7]};
        *(u32x4*)(bbt + (64 + pp) * 16) = (u32x4){hi_[0], hi_[1], hi_[2], hi_[3]}; *(u32x4*)(bbt + (64 + pp) * 16 + 8) = (u32x4){hi_[4], hi_[5], hi_[6], hi_[7]};
        *(u32x4*)(bbt + (128 + pp) * 16) = (u32x4){lr_[0], lr_[1], lr_[2], lr_[3]}; *(u32x4*)(bbt + (128 + pp) * 16 + 8) = (u32x4){lr_[4], lr_[5], lr_[6], lr_[7]};
        *(u32x4*)(bbt + (192 + pp) * 16) = (u32x4){li_[0], li_[1], li_[2], li_[3]}; *(u32x4*)(bbt + (192 + pp) * 16 + 8) = (u32x4){li_[4], li_[5], li_[6], li_[7]};
    }
    {
        u32x4 v[2];
#pragma unroll
        for (int i = 0; i < 2; ++i) { const int pc = tid + i * NTHR, t = pc >> 4, c8 = pc & 15; v[i] = *(const u32x4*)(P + (size_t)(trow0 + t) * PW + PC_S5 + half * 128 + c8 * 8); }
#pragma unroll
        for (int i = 0; i < 2; ++i) { const int pc = tid + i * NTHR, t = pc >> 4, c8 = pc & 15; *(u32x4*)(usb + t * 136 + c8 * 8) = v[i]; }
    }
    __syncthreads();
    const bf16x8 zf = (bf16x8){0, 0, 0, 0, 0, 0, 0, 0};
    bf16x8 bfr[8], bfl[8];
#pragma unroll
    for (int tile = 0; tile < 8; ++tile) { bfr[tile] = (kq < 2) ? *(const bf16x8*)(bbt + (16 * tile + l15) * 16 + 8 * kq) : zf; bfl[tile] = (kq < 2) ? *(const bf16x8*)(bbt + (128 + 16 * tile + l15) * 16 + 8 * kq) : zf; }
    __syncthreads();
    float xr = 0.f, xi = 0.f;
    bf16x8 cf[4]; float dd = 0.f;
    if (MODE == 3) {
        const f32x2 s0 = *st; xr = s0.x; xi = s0.y;
        const float* crp = p.in[16] + ((size_t)gi * 16 + l15) * 64; const float* cip = p.in[17] + ((size_t)gi * 16 + l15) * 64;
#pragma unroll
        for (int s = 0; s < 4; ++s)
#pragma unroll
            for (int j = 0; j < 8; ++j) { const int k = 32 * s + 8 * kq + j; cf[s][j] = (short)f2bf(k < 64 ? crp[k] : -cip[k - 64]); }
        dd = p.in[18][gi * 16 + l15];
    }
    bf16_t* ygl = (bf16_t*)(p.ws + WS_YGL);
    for (int t16 = 0; t16 < 4; ++t16) {
        const bf16x8 af = (kq < 2) ? *(const bf16x8*)(usb + (t16 * 16 + l15) * 136 + wid * 16 + 8 * kq) : zf;
#pragma unroll
        for (int tile = 0; tile < 8; ++tile) { const f32x4 a4 = MFMA16(af, bfr[tile], MFMA16(af, bfl[tile], ((f32x4){0.f, 0.f, 0.f, 0.f})));
#pragma unroll
            for (int j = 0; j < 4; ++j) buw[(4 * kq + j) * 128 + 16 * tile + l15] = f2bf(a4[j]); }
        __syncthreads();
#pragma unroll 4
        for (int tt = 0; tt < 16; ++tt) {
            const float bur = bf2f(buw[tt * 128 + pp]), bui = bf2f(buw[tt * 128 + 64 + pp]);
            const float nxr = ar * xr - ai * xi + bur, nxi = ar * xi + ai * xr + bui; xr = nxr; xi = nxi;
            if (MODE == 3) { Xw[tt * 136 + pp] = f2bf(xr); Xw[tt * 136 + 64 + pp] = f2bf(xi); }
        }
        __syncthreads();
        if (MODE == 3) {
            f32x4 a4 = (f32x4){0.f, 0.f, 0.f, 0.f};
#pragma unroll
            for (int s = 0; s < 4; ++s) { const bf16x8 a = *(const bf16x8*)(Xw + l15 * 136 + 32 * s + 8 * kq); a4 = MFMA16(a, cf[s], a4); }
#pragma unroll
            for (int j = 0; j < 4; ++j) { const int t = t16 * 16 + 4 * kq + j;
                const float y = a4[j] + dd * bf2f(usb[t * 136 + wid * 16 + l15]);
                ygl[(size_t)(trow0 + t) * 256 + g * 16 + l15] = f2bf(geluf_(y)); }
            __syncthreads();
        }
    }
    if (MODE == 1) *st = (f32x2){xr, xi};
    __syncthreads();
}

template <int MODE>
DI void lru_item(const Ctx& p, int l, int item, char* lds) {
    const int tid = otid(p.wbase), lane = tid & 63, wid = p.wbase >> 6, sub = tid >> 8, ch = tid & 255, r = lane & 31, hh = lane >> 5;
    const int b = item >> 6, n64 = item & 63, trow0 = b * SEQ + n64 * 64, s0 = n64 * 64;
    const bf16_t* P = (const bf16_t*)(p.ws + WS_R);
    bf16_t* xcb = (bf16_t*)lds;
    bf16_t* rawy = (bf16_t*)(lds + 33792);
    bf16_t* gb = (bf16_t*)(lds + 67584);
    bf16_t* rawx = (bf16_t*)(lds + 67584);
    const int tl = sub * 32;
    const int nb = wid >> 1, gate = wid & 1;
    bf16x8 wf[2][4];
    { const bf16_t* wg = (const bf16_t*)(p.ws + WS_WLRU) + (size_t)(gate * 4 + nb) * 4096;
#pragma unroll
        for (int tj = 0; tj < 2; ++tj)
#pragma unroll
            for (int ks = 0; ks < 4; ++ks) wf[tj][ks] = *(const bf16x8*)(wg + (tj * 32 + r) * 64 + ks * 16 + 8 * hh); }
    {
        u32x4 vx[5], vy[4];
#pragma unroll
        for (int i = 0; i < 5; ++i) { const int pc = tid + i * NTHR; vx[i] = (u32x4){0u, 0u, 0u, 0u};
            if (pc < 67 * 32) { const int row = pc >> 5, c8 = pc & 31, tt = row - 3; if (s0 + tt >= 0) vx[i] = *(const u32x4*)(P + (ptrdiff_t)(trow0 + tt) * PW + PC_LX + c8 * 8); } }
        if (MODE == 3) {
#pragma unroll
            for (int i = 0; i < 4; ++i) { const int pc = tid + i * NTHR, row = pc >> 5, c8 = pc & 31; vy[i] = *(const u32x4*)(P + (size_t)(trow0 + row) * PW + PC_LY + c8 * 8); }
        }
#pragma unroll
        for (int i = 0; i < 5; ++i) { const int pc = tid + i * NTHR; if (pc < 67 * 32) { const int row = pc >> 5, c8 = pc & 31; *(u32x4*)(rawx + row * 264 + c8 * 8) = vx[i]; } }
        if (MODE == 3) {
#pragma unroll
            for (int i = 0; i < 4; ++i) { const int pc = tid + i * NTHR, row = pc >> 5, c8 = pc & 31; *(u32x4*)(rawy + row * 264 + c8 * 8) = vy[i]; }
        }
    }
    __syncthreads();
    {
        const float* cwp = p.in[22] + (size_t)l * 4 * 256 + ch;
        const float w0 = cwp[0], w1 = cwp[256], w2 = cwp[512], w3 = cwp[768], cb = p.in[23][l * 256 + ch];
        float x0 = bf2f(rawx[tl * 264 + ch]), x1 = bf2f(rawx[(tl + 1) * 264 + ch]), x2 = bf2f(rawx[(tl + 2) * 264 + ch]);
#pragma unroll 4
        for (int t = tl; t < tl + 32; ++t) { const float x3 = bf2f(rawx[(t + 3) * 264 + ch]);
            xcb[t * 264 + ch] = f2bf(w0 * x0 + w1 * x1 + w2 * x2 + w3 * x3 + cb); x0 = x1; x1 = x2; x2 = x3; }
    }
    __syncthreads();
    {
        const float* bias = p.in[gate ? 27 : 25] + l * 256 + nb * 64;
#pragma unroll
        for (int ti = 0; ti < 2; ++ti) {
            bf16x8 af[4];
#pragma unroll
            for (int ks = 0; ks < 4; ++ks) af[ks] = *(const bf16x8*)(xcb + (ti * 32 + r) * 264 + nb * 64 + ks * 16 + 8 * hh);
#pragma unroll
            for (int tj = 0; tj < 2; ++tj) { f32x16 a = zero16();
#pragma unroll
                for (int ks = 0; ks < 4; ++ks) a = MFMA32(af[ks], wf[tj][ks], a);
                const float bv = bias[tj * 32 + r];
#pragma unroll
                for (int i = 0; i < 16; ++i) gb[(gate * 64 + ti * 32 + crow(i, hh)) * 264 + nb * 64 + tj * 32 + r] = f2bf(sigmoidf_(a[i] + bv)); }
        }
    }
    __syncthreads();
    {
        const float sp = softplusf_(-p.in[28][l * 256 + ch]);
        f32x2* st = (f32x2*)(p.ws + WS_LRUST) + (size_t)(b * 128 + n64 * 2 + sub) * 256 + ch;
        float hst = 0.f, Acc = 1.f;
        if (MODE == 3) hst = (*st).x;
#pragma unroll 4
        for (int t = tl; t < tl + 32; ++t) {
            const float rg = bf2f(gb[t * 264 + ch]), ig = bf2f(gb[(64 + t) * 264 + ch]), xc = bf2f(xcb[t * 264 + ch]);
            const float la = -8.f * rg * sp, a = __expf(la), mult = sqrtf(neg_expm1(2.f * la));
            hst = a * hst + xc * ig * mult;
            if (MODE == 1) Acc *= a;
            else { const float y = bf2f(rawy[t * 264 + ch]);
                ((bf16_t*)(p.ws + WS_BR))[(size_t)(trow0 + t) * D + 512 + ch] = f2bf(hst * geluf_(y)); }
        }
        if (MODE == 1) *st = (f32x2){Acc, hst};
    }
    __syncthreads();
}

constexpr int N_GDN = 2048, N_RET = 2048, N_S5 = 1024, N_LRU = 512;
template <int MODE>
DI void phase_mix(const Ctx& p, int l, char* lds) {
    const int G = gridDim.x;
    for (int r = blockIdx.x; r < N_GDN; r += G) gdn_item<MODE>(p, l, r, lds);
    {
        RetRegs cur, nxt;
        int r = blockIdx.x;
        if (r < N_RET) ret_load<MODE>(p, r, cur);
        for (; r < N_RET; r += G) {
            const bool more = r + G < N_RET;
            if (more) ret_load<MODE>(p, r + G, nxt);
            ret_item<MODE>(p, l, r, lds, cur);
            if (more) cur = nxt;
        }
    }
    for (int r = blockIdx.x; r < N_S5; r += G) s5_item<MODE>(p, l, r, lds);
    for (int r = blockIdx.x; r < N_LRU; r += G) lru_item<MODE>(p, l, r, lds);
}
DI void phase_scan(const Ctx& p, int l, char* lds) {
    const int tid = otid(p.wbase), lane = tid & 63, wid = p.wbase >> 6;
    for (int it = blockIdx.x; it < 128 + 32 + 16 + 8; it += gridDim.x) {
        if (it < 128) {
            const int bh = it >> 2, qb = it & 3, kq = lane >> 4, col = lane & 15;
            float* base = (float*)(p.ws + WS_GMN) + (size_t)bh * 64 * 8192;
            f32x4* Sx = (f32x4*)lds;
            const bool act = wid < 4;
            const int d0 = 16 * wid + col;
            f32x4 mA[4][4], nN[4], sB[4], sOwn;
            const f32x4 z4 = (f32x4){0.f, 0.f, 0.f, 0.f};
#pragma unroll
            for (int q = 0; q < 4; ++q) { sB[q] = z4; nN[q] = z4;
#pragma unroll
                for (int s_ = 0; s_ < 4; ++s_) mA[s_][q] = z4; }
            sOwn = z4;
            if (act) {
#pragma unroll
                for (int s_ = 0; s_ < 4; ++s_) { const float* nx = base + (size_t)s_ * 8192;
#pragma unroll
                    for (int q = 0; q < 4; ++q) mA[s_][q] = *(const f32x4*)(nx + d0 * 64 + 16 * q + 4 * kq);
#pragma unroll
                    for (int r = 0; r < 4; ++r) nN[s_][r] = nx[4096 + (16 * wid + 4 * kq + r) * 64 + 16 * qb + col]; }
            }
            for (int n0 = 0; n0 < 64; n0 += 4) {
#pragma unroll
                for (int s_ = 0; s_ < 4; ++s_) { const int n = n0 + s_;
                    float* cur = base + (size_t)n * 8192;
                    if (act) {
                        f32x4 acc = nN[s_];
#pragma unroll
                        for (int r = 0; r < 4; ++r) cur[4096 + (16 * wid + 4 * kq + r) * 64 + 16 * qb + col] = sOwn[r];
#pragma unroll
                        for (int q = 0; q < 4; ++q)
#pragma unroll
                            for (int jj = 0; jj < 4; ++jj) acc = __builtin_amdgcn_mfma_f32_16x16x4f32(mA[s_][q][jj], sB[q][jj], acc, 0, 0, 0);
                        if (n + 4 < 64) { const float* nx = cur + 4 * 8192;
#pragma unroll
                            for (int q = 0; q < 4; ++q) mA[s_][q] = *(const f32x4*)(nx + d0 * 64 + 16 * q + 4 * kq);
#pragma unroll
                            for (int r = 0; r < 4; ++r) nN[s_][r] = nx[4096 + (16 * wid + 4 * kq + r) * 64 + 16 * qb + col]; }
                        sOwn = acc;
                        Sx[(n & 1) * 256 + wid * 64 + lane] = acc;
                    }
                    __syncthreads();
                    if (act) {
#pragma unroll
                        for (int q = 0; q < 4; ++q) sB[q] = Sx[(n & 1) * 256 + q * 64 + lane];
                    }
                }
            }
            __syncthreads();
        } else if (it < 160) {
            const int bh = it - 128, h = bh & 3;
            float gC = 1.f - exp2f(-5.f - (float)h); gC *= gC; gC *= gC; gC *= gC; gC *= gC; gC *= gC; gC *= gC;
            float* base = (float*)(p.ws + WS_RKV) + (size_t)bh * 64 * 4096 + tid * 8;
            f32x4 sA = (f32x4){0.f, 0.f, 0.f, 0.f}, sB = sA;
            for (int n = 0; n < 64; ++n) { float* cur = base + (size_t)n * 4096;
                const f32x4 kA = *(const f32x4*)cur, kB = *(const f32x4*)(cur + 4);
                *(f32x4*)cur = sA; *(f32x4*)(cur + 4) = sB;
                sA = sA * gC + kA; sB = sB * gC + kB; }
        } else if (it < 176) {
            const int r = it - 160, b = r >> 1, half = r & 1, g = half * 8 + wid, gi = l * 16 + g;
            const float dt = __expf(p.in[19][gi]), lr = p.in[12][gi * 64 + lane], li = p.in[13][gi * 64 + lane];
            const float mag = __expf(64.f * lr * dt); float sn, cs; sincosf(64.f * li * dt, &sn, &cs);
            const float ar = mag * cs, ai = mag * sn;
            f32x2* st = (f32x2*)(p.ws + WS_S5ST) + (size_t)b * 64 * 1024 + g * 64 + lane;
            float cr = 0.f, ci = 0.f;
            for (int n = 0; n < 64; ++n) { const f32x2 e = st[(size_t)n * 1024]; st[(size_t)n * 1024] = (f32x2){cr, ci};
                const float nr = ar * cr - ai * ci + e.x, ni = ar * ci + ai * cr + e.y; cr = nr; ci = ni; }
        } else {
            const int b = it - 176;
            if (tid < 256) { f32x2* st = (f32x2*)(p.ws + WS_LRUST) + (size_t)b * 128 * 256 + tid; float c = 0.f;
                for (int n = 0; n < 128; ++n) { const f32x2 e = st[(size_t)n * 256]; st[(size_t)n * 256] = (f32x2){c, 0.f}; c = e.x * c + e.y; } }
        }
    }
}

#define XB_TMO      128
#define XB_XCNT(j)  (256  + 64 * (j))
#define XB_XSUB(j)  (1280 + 64 * (j))
#define XB_XGEN(j)  (2304 + 64 * (j))
#define XB_TOP      3328
#define XB_TOPGEN   3392
#define XCD_BAR_WORDS 3456
#define XB_SPIN_CAP (1u << 18)
#define XB_LAS __attribute__((address_space(3)))

__device__ __forceinline__ unsigned xb_ld(unsigned* p)              { return __hip_atomic_load(p, __ATOMIC_RELAXED, __HIP_MEMORY_SCOPE_AGENT); }
__device__ __forceinline__ unsigned xb_add(unsigned* p, unsigned v) { return __hip_atomic_fetch_add(p, v, __ATOMIC_RELAXED, __HIP_MEMORY_SCOPE_AGENT); }
__device__ __forceinline__ unsigned xb_xcc_id() { return (unsigned)__builtin_amdgcn_s_getreg((3 << 11) | 20) & 0xFu; }
#define XB_SPIN(cond, bar) do { unsigned _sp = 0; while (cond) { __builtin_amdgcn_s_sleep(1); \
    if ((++_sp & 255u) == 0u) { if (xb_ld(&(bar)[XB_TMO])) break; if (_sp > XB_SPIN_CAP) { atomicAdd(&(bar)[XB_TMO], 1u); break; } } } } while (0)

struct XcdBarrier {
    unsigned* bar; unsigned x;
    volatile XB_LAS unsigned* st;
};

__device__ __forceinline__ XcdBarrier xcd_barrier_post(unsigned* bar, volatile XB_LAS unsigned* st, bool t0) {
    XcdBarrier b; b.bar = bar; b.x = xb_xcc_id(); b.st = st;
    if (t0) (void)xb_add(&bar[XB_XCNT(b.x)], 1u);
    return b;
}
__device__ __forceinline__ void xcd_barrier_complete(unsigned* bar, unsigned x, unsigned& nloc, unsigned& nx) {
    const unsigned G = gridDim.x * gridDim.y * gridDim.z;
    unsigned sum, cnt, mine, sp = 0u;
    for (;;) {
        sum = 0u; cnt = 0u; mine = 0u;
#pragma unroll
        for (unsigned j = 0; j < 16; ++j) { const unsigned c = xb_ld(&bar[XB_XCNT(j)]); sum += c; cnt += (c > 0u) ? 1u : 0u; mine = (j == x) ? c : mine; }
        if (sum == G) break;
        __builtin_amdgcn_s_sleep(1);
        if ((++sp & 255u) == 0u) { if (xb_ld(&bar[XB_TMO])) break; if (sp > XB_SPIN_CAP) { atomicAdd(&bar[XB_TMO], 1u); break; } }
    }
    nloc = mine > 0u ? mine : 1u; nx = cnt > 0u ? cnt : 1u;
}

__device__ __forceinline__ void xcd_barrier(const XcdBarrier& b, bool t0) {
    asm volatile("s_waitcnt vmcnt(0)" ::: "memory");
    __syncthreads();
    if (t0) {
        unsigned* bar = b.bar;
        __builtin_amdgcn_s_waitcnt(0);
        unsigned nloc = b.st[0], nx = b.st[1];
        if (nloc == 0u) { xcd_barrier_complete(bar, b.x, nloc, nx); b.st[0] = nloc; b.st[1] = nx; }
        const unsigned old = xb_add(&bar[XB_XSUB(b.x)], 1u);
        const unsigned gen = old / nloc;
        if (old + 1u == (gen + 1u) * nloc) {
            __builtin_amdgcn_fence(__ATOMIC_RELEASE, "agent");
            asm volatile("s_waitcnt vmcnt(0)" ::: "memory");
            const unsigned og = xb_add(&bar[XB_TOP], 1u);
            const unsigned tg = og / nx;
            if (og + 1u == (tg + 1u) * nx) xb_add(&bar[XB_TOPGEN], 1u);
            else XB_SPIN(xb_ld(&bar[XB_TOPGEN]) == tg, bar);
            __builtin_amdgcn_fence(__ATOMIC_ACQUIRE, "agent");
            xb_add(&bar[XB_XGEN(b.x)], 1u);
            asm volatile("s_waitcnt vmcnt(0)" ::: "memory");
        } else {
            XB_SPIN(xb_ld(&bar[XB_XGEN(b.x)]) == gen, bar);
            __builtin_amdgcn_fence(__ATOMIC_ACQUIRE, "agent");
            asm volatile("s_waitcnt vmcnt(0)" ::: "memory");
        }
    }
    __syncthreads();
}

#define CLOBBER_HI() asm volatile("" ::: "v72", "v73", "v74", "v75", "v76", "v77", "v78", "v79", "v80", "v81", "v82", "v83", "v84", "v85", "v86", "v87", "v88", "v89", "v90", "v91", "v92", "v93", "v94", "v95", "v96", "v97", "v98", "v99", "v100", "v101", "v102", "v103", "v104", "v105", "v106", "v107", "v108", "v109", "v110", "v111", "v112", "v113", "v114", "v115", "v116", "v117", "v118", "v119", "v120", "v121", "v122", "v123", "v124", "v125", "v126", "v127", "v128", "v129", "v130", "v131", "v132", "v133", "v134", "v135", "v136", "v137", "v138", "v139", "v140", "v141", "v142", "v143", "v144", "v145", "v146", "v147", "v148", "v149", "v150", "v151", "v152", "v153", "v154", "v155", "v156", "v157", "v158", "v159", "v160", "v161", "v162", "v163", "v164", "v165", "v166", "v167", "v168", "v169", "v170", "v171", "v172", "v173", "v174", "v175", "v176", "v177", "v178", "v179", "v180", "v181", "v182", "v183", "v184", "v185", "v186", "v187", "v188", "v189", "v190", "v191", "v192", "v193", "v194", "v195", "v196", "v197", "v198", "v199", "v200", "v201", "v202", "v203", "v204", "v205", "v206", "v207", "v208", "v209", "v210", "v211", "v212", "v213", "v214", "v215", "v216", "v217", "v218", "v219", "v220", "v221", "v222", "v223", "v224", "v225", "v226", "v227", "v228", "v229", "v230", "v231", "v232", "v233", "v234", "v235", "v236", "v237", "v238", "v239", "v240", "v241", "v242", "v243", "v244", "v245", "v246", "v247", "v248", "v249", "v250", "v251", "v252", "v253", "v254", "v255")
__global__ void __launch_bounds__(NTHR) mega(Params pp) {
    extern __shared__ __attribute__((aligned(16))) char lds[];
    cg::grid_group grid = cg::this_grid();
    Ctx p;
#pragma unroll
    for (int i = 0; i < 37; ++i) p.in[i] = pp.in[i];
    p.out = pp.out; p.ws = pp.ws; p.wbase = __builtin_amdgcn_readfirstlane((int)threadIdx.x & ~63);
    static_assert(XCD_BAR_WORDS_ == XCD_BAR_WORDS, "barrier words");
    volatile XB_LAS unsigned* xst = (volatile XB_LAS unsigned*)(XB_LAS unsigned char*)(lds + LDS_BAR_OFF);
    if (threadIdx.x == 0) { xst[0] = 0u; xst[1] = 0u; }
    __syncthreads();
    const XcdBarrier xb = xcd_barrier_post((unsigned*)(p.ws + WS_BAR), xst, threadIdx.x == 0);
#define GSYNC() do { xcd_barrier(xb, otid(p.wbase) == 0); CLOBBER_HI(); } while (0)
    for (int l = 0; l < DEPTH; ++l) {
        const float* xin = (l == 0) ? p.in[0] : p.out;
        const float* win_l = p.in[7] + (size_t)l * D * NIN;
        phase_wconv(p, l, lds);
        phase_norm<false>(p, xin, p.in[2] + l * D, win_l, lds);
        if (l == 0) { grid.sync(); CLOBBER_HI(); } else GSYNC();
        phase_ffn_a(p, (const bf16_t*)(p.ws + WS_WGU1), lds);
        GSYNC();
        phase_gemm_res(p, (const bf16_t*)(p.ws + WS_R), FF, (const bf16_t*)(p.ws + WS_WD1), xin, 0.5f, lds);
        GSYNC();
        phase_norm<true>(p, p.out, p.in[6] + l * D, win_l, lds);
        GSYNC();
        phase_proj(p, lds);
        GSYNC();
        phase_mix<1>(p, l, lds);
        GSYNC();
        phase_scan(p, l, lds);
        GSYNC();
        phase_mix<3>(p, l, lds);
        GSYNC();
        phase_glu(p, p.in[21] + l * 256, lds);
        GSYNC();
        phase_merge(p, lds);
        GSYNC();
        phase_gemm_res(p, (const bf16_t*)(p.ws + WS_R), D, (const bf16_t*)(p.ws + WS_WOUT), p.out, 1.0f, lds);
        GSYNC();
        phase_norm<false>(p, p.out, p.in[32] + l * D, win_l, lds);
        GSYNC();
        phase_ffn_a(p, (const bf16_t*)(p.ws + WS_WGU2), lds);
        GSYNC();
        phase_gemm_res(p, (const bf16_t*)(p.ws + WS_R), FF, (const bf16_t*)(p.ws + WS_WD2), p.out, 0.5f, lds);
        GSYNC();
    }
    phase_final_norm(p, p.in[36]);
}

extern "C" void kernel_launch(void* const* d_in, const int* in_sizes, int n_in, void* d_out, int out_size, void* d_ws, size_t ws_size, hipStream_t stream) {
    static int grid_blocks = 0;
    if (grid_blocks == 0) {
        if (n_in != 37 || ws_size < WS_END) { fprintf(stderr, "kernel_launch: unexpected n_in %d or ws_size %zu (< %zu)\n", n_in, ws_size, (size_t)WS_END); grid_blocks = -1; return; }
        int dev = 0, cus = 0, per_cu = 0;
        hipGetDevice(&dev);
        hipDeviceGetAttribute(&cus, hipDeviceAttributeMultiprocessorCount, dev);
        hipFuncSetAttribute((const void*)mega, hipFuncAttributeMaxDynamicSharedMemorySize, LDS_BYTES);
        hipOccupancyMaxActiveBlocksPerMultiprocessor(&per_cu, (const void*)mega, NTHR, LDS_BYTES);
        if (per_cu < 1) per_cu = 1;
        grid_blocks = cus * per_cu; if (grid_blocks > 256) grid_blocks = 256;
        fprintf(stderr, "kernel_launch: cus %d per_cu %d grid %d ws %zu need %zu\n", cus, per_cu, grid_blocks, ws_size, (size_t)WS_END);
    }
    if (grid_blocks < 0) return;
    Params p{};
    for (int i = 0; i < 37; ++i) p.in[i] = (const float*)d_in[i];
    p.out = (float*)d_out; p.ws = (char*)d_ws;
    (void)hipMemsetAsync((char*)d_ws + WS_BAR, 0, (size_t)XCD_BAR_WORDS_ * 4, stream);
    void* args[] = {&p};
    hipError_t e = hipLaunchCooperativeKernel((const void*)mega, dim3(grid_blocks), dim3(NTHR), args, LDS_BYTES, stream);
    if (e != hipSuccess) fprintf(stderr, "cooperative launch failed: %s (grid %d)\n", hipGetErrorString(e), grid_blocks);
}
```
